# Optimizing an MI355X kernel written in HIP

```python
import math
import jax, jax.numpy as jnp
from jax import lax
import numpy as np

D_MODEL = 1024
BATCH = 4
SEQ = 4096
DEPTH = 1

D_CONV = D_MODEL // 2
D_SSM = D_MODEL // 2
D_MIX = D_CONV + D_SSM
CONV_WIDTH = 31
SSM_GROUP = 16
N_SSM_GROUPS = D_SSM // SSM_GROUP
SSM_STATE = 64
DT_MIN = 1e-3
DT_MAX = 1e-1
MEM_LEN = 256
N_XHEADS = 4
XHEAD_DIM = D_MODEL // N_XHEADS
N_EXPERTS = 256
TOP_K = 8
N_EXPERT_GROUPS = 8
TOPK_GROUPS = 4
D_EXPERT = D_MODEL // 4
D_SHARED = D_EXPERT
ROUTED_SCALE = 2.5
MOE_BLOCK = 128
DEEPNORM_ALPHA = (2 * DEPTH) ** 0.25
DEEPNORM_BETA = (8 * DEPTH) ** -0.25
EPS = 1e-5

kernel_name = 'hybrid_conv_s5_memxattn_moe_deepnorm'


def layer_norm(x, g, b):
    xf = x.astype(jnp.float32)
    mu = jnp.mean(xf, -1, keepdims=True)
    var = jnp.mean(jnp.square(xf - mu), -1, keepdims=True)
    return ((xf - mu) * lax.rsqrt(var + EPS) * g + b).astype(x.dtype)


def rms_norm(x, g):
    xf = x.astype(jnp.float32)
    return (xf * lax.rsqrt(jnp.mean(jnp.square(xf), -1, keepdims=True) + EPS) * g).astype(x.dtype)


def conformer_conv(h, conv_w, conv_b, ln_g, ln_b):
    y = lax.conv_general_dilated(h, conv_w[:, None, :], window_strides=(1,),
                                 padding=[(CONV_WIDTH - 1, 0)],
                                 dimension_numbers=('NWC', 'WIO', 'NWC'),
                                 feature_group_count=D_CONV) + conv_b
    return jax.nn.silu(layer_norm(y, ln_g, ln_b))


def complex_linear_combine(e1, e2):
    a1r, a1i, b1r, b1i = e1
    a2r, a2i, b2r, b2i = e2
    return (a2r * a1r - a2i * a1i,
            a2r * a1i + a2i * a1r,
            a2r * b1r - a2i * b1i + b2r,
            a2r * b1i + a2i * b1r + b2i)


def s5_ssm(u, log_dt, a_re, a_im, b_re, b_im, c_re, c_im, d_skip, w_glu, b_glu):
    f32 = jnp.float32
    bsz, seq, _ = u.shape
    uf = u.astype(f32)
    ug = uf.reshape(bsz, seq, N_SSM_GROUPS, SSM_GROUP)
    a_re = a_re.astype(f32)
    a_im = a_im.astype(f32)
    dt = jnp.exp(log_dt.astype(f32))[:, None]
    mag = jnp.exp(a_re * dt)
    ang = a_im * dt
    lb_re = mag * jnp.cos(ang)
    lb_im = mag * jnp.sin(ang)
    den = a_re * a_re + a_im * a_im
    coef_re = ((lb_re - 1.0) * a_re + lb_im * a_im) / den
    coef_im = (lb_im * a_re - (lb_re - 1.0) * a_im) / den
    b_re = b_re.astype(f32)
    b_im = b_im.astype(f32)
    bb_re = coef_re[..., None] * b_re - coef_im[..., None] * b_im
    bb_im = coef_re[..., None] * b_im + coef_im[..., None] * b_re
    bu_re = jnp.einsum('blgh,gph->blgp', ug, bb_re)
    bu_im = jnp.einsum('blgh,gph->blgp', ug, bb_im)
    lam_re = jnp.broadcast_to(lb_re, (1, seq, N_SSM_GROUPS, SSM_STATE))
    lam_im = jnp.broadcast_to(lb_im, (1, seq, N_SSM_GROUPS, SSM_STATE))
    _, _, s_re, s_im = lax.associative_scan(complex_linear_combine,
                                            (lam_re, lam_im, bu_re, bu_im), axis=1)
    y = (jnp.einsum('blgp,ghp->blgh', s_re, c_re.astype(f32))
         - jnp.einsum('blgp,ghp->blgh', s_im, c_im.astype(f32)))
    y = y.reshape(bsz, seq, D_SSM) + d_skip.astype(f32) * uf
    z = jax.nn.gelu(y)
    z = z * jax.nn.sigmoid(z @ w_glu.astype(f32) + b_glu.astype(f32))
    return z.astype(u.dtype)


def hybrid_mixer(x, w_in, conv_w, conv_b, conv_ln_g, conv_ln_b, ssm_log_dt, ssm_a_re, ssm_a_im,
                 ssm_b_re, ssm_b_im, ssm_c_re, ssm_c_im, ssm_d, w_glu, b_glu,
                 g_conv_out, g_ssm_out, w_out):
    proj = x @ w_in
    conv_val, conv_gate, ssm_u = jnp.split(proj, [D_CONV, 2 * D_CONV], axis=-1)
    conv_out = conformer_conv(conv_val * jax.nn.sigmoid(conv_gate), conv_w, conv_b,
                              conv_ln_g, conv_ln_b)
    ssm_out = s5_ssm(ssm_u, ssm_log_dt, ssm_a_re, ssm_a_im, ssm_b_re, ssm_b_im,
                     ssm_c_re, ssm_c_im, ssm_d, w_glu, b_glu)
    merged = jnp.concatenate([rms_norm(conv_out, g_conv_out), rms_norm(ssm_out, g_ssm_out)], -1)
    return merged @ w_out


def memory_cross_attention(x, mem, wq, wk, wv, wo):
    bsz, seq, d = x.shape
    q = (x @ wq).reshape(bsz, seq, N_XHEADS, XHEAD_DIM)
    k = (mem @ wk).reshape(bsz, MEM_LEN, N_XHEADS, XHEAD_DIM)
    v = (mem @ wv).reshape(bsz, MEM_LEN, N_XHEADS, XHEAD_DIM)
    s = jnp.einsum('blhd,bmhd->bhlm', q, k).astype(jnp.float32) * (XHEAD_DIM ** -0.5)
    p = jax.nn.softmax(s, axis=-1).astype(v.dtype)
    o = jnp.einsum('bhlm,bmhd->blhd', p, v).reshape(bsz, seq, d)
    return o @ wo


def moe_ffn(x, w_router, router_bias, w_gate, w_up, w_down, sh_gate, sh_up, sh_down):
    bsz, seq, d = x.shape
    n_tok = bsz * seq
    xt = x.reshape(n_tok, d)
    scores = jax.nn.sigmoid((xt @ w_router).astype(jnp.float32))
    biased = scores + router_bias.astype(jnp.float32)
    grouped = biased.reshape(n_tok, N_EXPERT_GROUPS, N_EXPERTS // N_EXPERT_GROUPS)
    group_score = lax.top_k(grouped, 2)[0].sum(-1)
    top_groups = lax.top_k(group_score, TOPK_GROUPS)[1]
    group_mask = jax.nn.one_hot(top_groups, N_EXPERT_GROUPS, dtype=jnp.float32).sum(1) > 0
    masked = jnp.where(group_mask[:, :, None], grouped, -jnp.inf).reshape(n_tok, N_EXPERTS)
    top_idx = lax.top_k(masked, TOP_K)[1]
    gates = jnp.take_along_axis(scores, top_idx, axis=1)
    gates = ROUTED_SCALE * gates / jnp.sum(gates, -1, keepdims=True)
    n_assign = n_tok * TOP_K
    n_pad = -(-(n_assign + N_EXPERTS * MOE_BLOCK) // MOE_BLOCK) * MOE_BLOCK
    n_blocks = n_pad // MOE_BLOCK
    expert_flat = top_idx.reshape(-1)
    order = jnp.argsort(expert_flat)
    sorted_expert = expert_flat[order]
    sorted_tok = (order // TOP_K).astype(jnp.int32)
    sorted_gate = gates.reshape(-1)[order]
    counts = jnp.bincount(expert_flat, length=N_EXPERTS)
    starts = jnp.cumsum(counts) - counts
    padded = (counts + MOE_BLOCK - 1) // MOE_BLOCK * MOE_BLOCK
    pad_ends = jnp.cumsum(padded)
    pad_starts = pad_ends - padded
    dest = pad_starts[sorted_expert] + jnp.arange(n_assign) - starts[sorted_expert]
    pad_tok = jnp.full((n_pad,), n_tok, jnp.int32).at[dest].set(sorted_tok)
    pad_gate = jnp.zeros((n_pad,), x.dtype).at[dest].set(sorted_gate.astype(x.dtype))
    block_expert = jnp.minimum(
        jnp.searchsorted(pad_ends, jnp.arange(n_blocks) * MOE_BLOCK, side='right'), N_EXPERTS - 1)
    x_padded = jnp.concatenate([xt, jnp.zeros((1, d), x.dtype)], 0)

    def expert_block(args):
        e, tok = args
        xb = x_padded[tok]
        h = jax.nn.silu(xb @ w_gate[e]) * (xb @ w_up[e])
        return h @ w_down[e]

    y = lax.map(expert_block, (block_expert, pad_tok.reshape(n_blocks, MOE_BLOCK)))
    y = y.reshape(n_pad, d) * pad_gate[:, None]
    routed = jnp.zeros((n_tok + 1, d), x.dtype).at[pad_tok].add(y)[:n_tok]
    shared = (jax.nn.silu(xt @ sh_gate) * (xt @ sh_up)) @ sh_down
    return (routed + shared).reshape(bsz, seq, d)


def setup_inputs(seed: int = 0) -> dict:
    key = jax.random.key(seed)
    ks = iter(jax.random.split(key, 40))
    f32 = jnp.float32
    G, P, H = N_SSM_GROUPS, SSM_STATE, SSM_GROUP

    def nrm(shape, scale):
        return jax.random.normal(next(ks), shape, f32) * scale

    def gain(shape):
        return 1.0 + nrm(shape, 0.02)

    beta = DEEPNORM_BETA
    x = nrm((BATCH, SEQ, D_MODEL), 1.0)
    mem = nrm((BATCH, MEM_LEN, D_MODEL), 1.0)
    w_in = nrm((DEPTH, D_MODEL, 2 * D_CONV + D_SSM), D_MODEL ** -0.5)
    conv_w = nrm((DEPTH, CONV_WIDTH, D_CONV), CONV_WIDTH ** -0.5)
    conv_b = nrm((DEPTH, D_CONV), 0.02)
    conv_ln_g = gain((DEPTH, D_CONV))
    conv_ln_b = nrm((DEPTH, D_CONV), 0.02)
    ssm_log_dt = jax.random.uniform(next(ks), (DEPTH, G), f32, math.log(DT_MIN), math.log(DT_MAX))
    ssm_a_re = -0.5 + nrm((DEPTH, G, P), 0.01)
    ssm_a_im = jnp.pi * jnp.arange(P, dtype=f32) + nrm((DEPTH, G, P), 0.01)
    ssm_b_re = nrm((DEPTH, G, P, H), (2 * H) ** -0.5)
    ssm_b_im = nrm((DEPTH, G, P, H), (2 * H) ** -0.5)
    ssm_c_re = nrm((DEPTH, G, H, P), (2 * P) ** -0.5)
    ssm_c_im = nrm((DEPTH, G, H, P), (2 * P) ** -0.5)
    ssm_d = nrm((DEPTH, D_SSM), 1.0)
    w_glu = nrm((DEPTH, D_SSM, D_SSM), D_SSM ** -0.5)
    b_glu = nrm((DEPTH, D_SSM), 0.02)
    g_conv_out = gain((DEPTH, D_CONV))
    g_ssm_out = gain((DEPTH, D_SSM))
    w_out = nrm((DEPTH, D_MIX, D_MODEL), beta * D_MIX ** -0.5)
    ln1_g = gain((DEPTH, D_MODEL))
    ln1_b = nrm((DEPTH, D_MODEL), 0.02)
    wq = nrm((DEPTH, D_MODEL, D_MODEL), D_MODEL ** -0.5)
    wk = nrm((DEPTH, D_MODEL, D_MODEL), D_MODEL ** -0.5)
    wv = nrm((DEPTH, D_MODEL, D_MODEL), beta * D_MODEL ** -0.5)
    wo = nrm((DEPTH, D_MODEL, D_MODEL), beta * D_MODEL ** -0.5)
    ln2_g = gain((DEPTH, D_MODEL))
    ln2_b = nrm((DEPTH, D_MODEL), 0.02)
    w_router = nrm((DEPTH, D_MODEL, N_EXPERTS), D_MODEL ** -0.5)
    router_bias = nrm((DEPTH, N_EXPERTS), 0.01)
    w_gate = nrm((DEPTH, N_EXPERTS, D_MODEL, D_EXPERT), D_MODEL ** -0.5)
    w_up = nrm((DEPTH, N_EXPERTS, D_MODEL, D_EXPERT), D_MODEL ** -0.5)
    w_down = nrm((DEPTH, N_EXPERTS, D_EXPERT, D_MODEL), beta * D_EXPERT ** -0.5)
    sh_gate = nrm((DEPTH, D_MODEL, D_SHARED), D_MODEL ** -0.5)
    sh_up = nrm((DEPTH, D_MODEL, D_SHARED), D_MODEL ** -0.5)
    sh_down = nrm((DEPTH, D_SHARED, D_MODEL), beta * D_SHARED ** -0.5)
    ln3_g = gain((DEPTH, D_MODEL))
    ln3_b = nrm((DEPTH, D_MODEL), 0.02)
    return {'x': x, 'mem': mem, 'w_in': w_in, 'conv_w': conv_w, 'conv_b': conv_b,
            'conv_ln_g': conv_ln_g, 'conv_ln_b': conv_ln_b, 'ssm_log_dt': ssm_log_dt,
            'ssm_a_re': ssm_a_re, 'ssm_a_im': ssm_a_im, 'ssm_b_re': ssm_b_re, 'ssm_b_im': ssm_b_im,
            'ssm_c_re': ssm_c_re, 'ssm_c_im': ssm_c_im, 'ssm_d': ssm_d, 'w_glu': w_glu,
            'b_glu': b_glu, 'g_conv_out': g_conv_out, 'g_ssm_out': g_ssm_out, 'w_out': w_out,
            'ln1_g': ln1_g, 'ln1_b': ln1_b, 'wq': wq, 'wk': wk, 'wv': wv, 'wo': wo,
            'ln2_g': ln2_g, 'ln2_b': ln2_b, 'w_router': w_router, 'router_bias': router_bias,
            'w_gate': w_gate, 'w_up': w_up, 'w_down': w_down, 'sh_gate': sh_gate,
            'sh_up': sh_up, 'sh_down': sh_down, 'ln3_g': ln3_g, 'ln3_b': ln3_b}


def reference(x, mem, w_in, conv_w, conv_b, conv_ln_g, conv_ln_b, ssm_log_dt, ssm_a_re, ssm_a_im,
              ssm_b_re, ssm_b_im, ssm_c_re, ssm_c_im, ssm_d, w_glu, b_glu, g_conv_out, g_ssm_out,
              w_out, ln1_g, ln1_b, wq, wk, wv, wo, ln2_g, ln2_b, w_router, router_bias,
              w_gate, w_up, w_down, sh_gate, sh_up, sh_down, ln3_g, ln3_b):
    for l in range(DEPTH):
        mix = hybrid_mixer(x, w_in[l], conv_w[l], conv_b[l], conv_ln_g[l], conv_ln_b[l],
                           ssm_log_dt[l], ssm_a_re[l], ssm_a_im[l], ssm_b_re[l], ssm_b_im[l],
                           ssm_c_re[l], ssm_c_im[l], ssm_d[l], w_glu[l], b_glu[l],
                           g_conv_out[l], g_ssm_out[l], w_out[l])
        x = layer_norm(DEEPNORM_ALPHA * x + mix, ln1_g[l], ln1_b[l])
        xa = memory_cross_attention(x, mem, wq[l], wk[l], wv[l], wo[l])
        x = layer_norm(DEEPNORM_ALPHA * x + xa, ln2_g[l], ln2_b[l])
        ff = moe_ffn(x, w_router[l], router_bias[l], w_gate[l], w_up[l], w_down[l],
                     sh_gate[l], sh_up[l], sh_down[l])
        x = layer_norm(DEEPNORM_ALPHA * x + ff, ln3_g[l], ln3_b[l])
    return x
```

```cpp
#include <hip/hip_runtime.h>
#include <cstdio>
#include <cstdint>

#ifndef MK_SPLIT
#define MK_SPLIT 0
#endif

#define GAS __attribute__((address_space(1)))
#define LAS __attribute__((address_space(3)))
typedef unsigned short bf16;
typedef short bf16x8 __attribute__((ext_vector_type(8)));
typedef float f32x4 __attribute__((ext_vector_type(4)));
typedef unsigned v4u __attribute__((ext_vector_type(4)));
typedef unsigned v2u __attribute__((ext_vector_type(2)));
#define RLX_AGENT __ATOMIC_RELAXED, __HIP_MEMORY_SCOPE_AGENT
#define LDS_WAIT() asm volatile("s_waitcnt lgkmcnt(0)" ::: "memory")

constexpr int NB = 4, SEQ = 4096, T = NB * SEQ, D = 1024;
constexpr int DC = 512, DS = 512, CW = 31, NG = 32, GH = 16, PS = 64;
constexpr int LC = 16, NCH = T / LC;
constexpr int MEML = 256, NXH = 4, XHD = 256;
constexpr int NE = 256, TOPK = 8, NEG = 8, TKG = 4, DE = 256;
constexpr int NASSIGN = T * TOPK;
constexpr float ALPHA = 1.189207115002721f;
constexpr float EPS = 1e-5f;
constexpr float ROUTED_SCALE = 2.5f;
constexpr int NWAVES = 8, NTHR = 512;

constexpr size_t MiB = 1u << 20;
constexpr size_t WS_CTL = 0, CTL_ZERO_BYTES = 1 * MiB;
constexpr size_t WS_W_IN_T = 1 * MiB;
constexpr size_t WS_W_GLU_T = 4 * MiB;
constexpr size_t WS_W_OUT_T = 5 * MiB;
constexpr size_t WS_WQ_T = 7 * MiB;
constexpr size_t WS_WKV_T = 9 * MiB;
constexpr size_t WS_WO_T = 13 * MiB;
constexpr size_t WS_WR_T = 15 * MiB;
constexpr size_t WS_SSM_W1 = 16 * MiB;
constexpr size_t WS_SSM_W2 = 18 * MiB;
constexpr size_t WS_SH_GU_T = 24 * MiB;
constexpr size_t WS_SH_D_T = 25 * MiB;
constexpr size_t WS_LAM16 = 25 * MiB + 512 * 1024;
constexpr size_t WS_MEMB = 26 * MiB;
constexpr size_t WS_KB = 28 * MiB;
constexpr size_t WS_VT = 30 * MiB;
constexpr size_t WS_WGU_T = 32 * MiB;
constexpr size_t WS_WD_T = 288 * MiB;
constexpr size_t WS_X2 = 416 * MiB;
constexpr size_t WS_X2B = 480 * MiB;
constexpr size_t WS_Y = 512 * MiB;
constexpr size_t WS_XB = 512 * MiB;
constexpr size_t WS_CV = 544 * MiB;
constexpr size_t WS_AS = 576 * MiB;
constexpr size_t WS_SEND = 600 * MiB;
constexpr size_t WS_Z = 616 * MiB;
constexpr size_t WS_ZG = 632 * MiB;
constexpr size_t WS_MERGED = 664 * MiB;
constexpr size_t WS_Y1 = 696 * MiB;
constexpr size_t WS_H = 768 * MiB;
constexpr size_t WS_Q = 768 * MiB;
constexpr size_t WS_O = 800 * MiB;
constexpr size_t WS_X1 = 832 * MiB;
constexpr size_t WS_X1B = 896 * MiB;
constexpr size_t WS_YS = 832 * MiB;
constexpr size_t WS_HS = 864 * MiB;
constexpr size_t WS_LOGITS = 872 * MiB;
constexpr size_t WS_TOPE = 928 * MiB;
constexpr size_t WS_TOPP = 928 * MiB + 512 * 1024;
constexpr size_t WS_GATE = 929 * MiB;
constexpr size_t WS_SLOT = 929 * MiB + 512 * 1024;
constexpr size_t WS_STOK = 930 * MiB;
constexpr size_t WS_SGATE = 930 * MiB + 512 * 1024;
constexpr size_t WS_END = 931 * MiB;
constexpr int CW_BAR = 4096;
constexpr int CW_CNT = 16384;

constexpr int LDS_BYTES = 147456;
constexpr int MISC_OFF = 131072 + 320;

__device__ __forceinline__ unsigned f2bf(float f) { unsigned u = __builtin_bit_cast(unsigned, f); return (u + 0x7fffu + ((u >> 16) & 1u)) >> 16; }
__device__ __forceinline__ unsigned pk2(float lo, float hi) { return f2bf(lo) | (f2bf(hi) << 16); }
__device__ __forceinline__ float bf2f(unsigned h) { return __builtin_bit_cast(float, h << 16); }
__device__ __forceinline__ float bflo(unsigned w) { return __builtin_bit_cast(float, w << 16); }
__device__ __forceinline__ float bfhi(unsigned w) { return __builtin_bit_cast(float, w & 0xffff0000u); }
__device__ __forceinline__ float sigmoidf_(float x) { return 1.0f / (1.0f + __expf(-x)); }
__device__ __forceinline__ float wave_sum(float v) {
#pragma unroll
    for (int o = 1; o < 64; o <<= 1) v += __shfl_xor(v, o);
    return v;
}
__device__ __forceinline__ float gelu_tanh(float x) {
    const float u = 0.7978845608028654f * (x + 0.044715f * x * x * x);
    const float t = 1.0f - 2.0f / (1.0f + __expf(2.0f * u));
    return 0.5f * x * (1.0f + t);
}

#define XB_TMO      128
#define XB_XCNT(j)  (256  + 64 * (j))
#define XB_XSUB(j)  (1280 + 64 * (j))
#define XB_XGEN(j)  (2304 + 64 * (j))
#define XB_TOP      3328
#define XB_TOPGEN   3392
#define XCD_BAR_WORDS 3456
#define XB_SPIN_CAP (1u << 20)

__device__ __forceinline__ unsigned xb_ld(unsigned* p)              { return __hip_atomic_load(p, __ATOMIC_RELAXED, __HIP_MEMORY_SCOPE_AGENT); }
__device__ __forceinline__ unsigned xb_add(unsigned* p, unsigned v) { return __hip_atomic_fetch_add(p, v, __ATOMIC_RELAXED, __HIP_MEMORY_SCOPE_AGENT); }
__device__ __forceinline__ unsigned xb_xcc_id() { return (unsigned)__builtin_amdgcn_s_getreg((3 << 11) | 20) & 0xFu; }
#define XB_SPIN(cond, bar) do { unsigned _sp = 0; while (cond) { __builtin_amdgcn_s_sleep(1); \
    if ((++_sp & 255u) == 0u) { if (xb_ld(&(bar)[XB_TMO])) break; if (_sp > XB_SPIN_CAP) { atomicAdd(&(bar)[XB_TMO], 1u); break; } } } } while (0)

struct XcdBarrier { unsigned* bar; unsigned x; volatile LAS unsigned* st; };

__device__ __forceinline__ XcdBarrier xcd_barrier_post(unsigned* bar, volatile LAS unsigned* st) {
    XcdBarrier b; b.bar = bar; b.x = xb_xcc_id(); b.st = st;
    if (threadIdx.x == 0) (void)xb_add(&bar[XB_XCNT(b.x)], 1u);
    return b;
}
__device__ __forceinline__ void xcd_barrier_complete(unsigned* bar, unsigned x, unsigned& nloc, unsigned& nx) {
    const unsigned G = gridDim.x * gridDim.y * gridDim.z;
    unsigned sum, cnt, mine, sp = 0u;
    for (;;) {
        sum = 0u; cnt = 0u; mine = 0u;
#pragma unroll
        for (unsigned j = 0; j < 16; ++j) { const unsigned c = xb_ld(&bar[XB_XCNT(j)]); sum += c; cnt += (c > 0u) ? 1u : 0u; mine = (j == x) ? c : mine; }
        if (sum == G) break;
        __builtin_amdgcn_s_sleep(1);
        if ((++sp & 255u) == 0u) { if (xb_ld(&bar[XB_TMO])) break; if (sp > XB_SPIN_CAP) { atomicAdd(&bar[XB_TMO], 1u); break; } }
    }
    nloc = mine > 0u ? mine : 1u; nx = cnt > 0u ? cnt : 1u;
}
__device__ __forceinline__ void xcd_barrier(const XcdBarrier& b) {
    asm volatile("s_waitcnt vmcnt(0)" ::: "memory");
    __syncthreads();
    if (threadIdx.x == 0) {
        unsigned* bar = b.bar;
        __builtin_amdgcn_s_waitcnt(0);
        unsigned nloc = b.st[0], nx = b.st[1];
        if (nloc == 0u) { xcd_barrier_complete(bar, b.x, nloc, nx); b.st[0] = nloc; b.st[1] = nx; }
        const unsigned old = xb_add(&bar[XB_XSUB(b.x)], 1u);
        const unsigned gen = old / nloc;
        if (old + 1u == (gen + 1u) * nloc) {
            __builtin_amdgcn_fence(__ATOMIC_RELEASE, "agent");
            asm volatile("s_waitcnt vmcnt(0)" ::: "memory");
            const unsigned og = xb_add(&bar[XB_TOP], 1u);
            const unsigned tg = og / nx;
            if (og + 1u == (tg + 1u) * nx) xb_add(&bar[XB_TOPGEN], 1u);
            else XB_SPIN(xb_ld(&bar[XB_TOPGEN]) == tg, bar);
            __builtin_amdgcn_fence(__ATOMIC_ACQUIRE, "agent");
            xb_add(&bar[XB_XGEN(b.x)], 1u);
            asm volatile("s_waitcnt vmcnt(0)" ::: "memory");
        } else {
            XB_SPIN(xb_ld(&bar[XB_XGEN(b.x)]) == gen, bar);
            __builtin_amdgcn_fence(__ATOMIC_ACQUIRE, "agent");
            asm volatile("s_waitcnt vmcnt(0)" ::: "memory");
        }
    }
    __syncthreads();
}

template <int MI, int NJ>
__device__ __forceinline__ void wave_mma(const bf16* (&ar)[MI], const bf16* (&br)[NJ], int K, f32x4 (&acc)[MI][NJ]) {
#pragma unroll 2
    for (int k = 0; k < K; k += 32) {
        bf16x8 a[MI], b[NJ];
#pragma unroll
        for (int i = 0; i < MI; ++i) a[i] = *(const bf16x8*)(ar[i] + k);
#pragma unroll
        for (int j = 0; j < NJ; ++j) b[j] = *(const bf16x8*)(br[j] + k);
#pragma unroll
        for (int i = 0; i < MI; ++i)
#pragma unroll
            for (int j = 0; j < NJ; ++j) acc[i][j] = __builtin_amdgcn_mfma_f32_16x16x32_bf16(b[j], a[i], acc[i][j], 0, 0, 0);
    }
}
template <int MI, int NJ>
__device__ __forceinline__ void zero_acc(f32x4 (&acc)[MI][NJ]) {
#pragma unroll
    for (int i = 0; i < MI; ++i)
#pragma unroll
        for (int j = 0; j < NJ; ++j) acc[i][j] = (f32x4){0.f, 0.f, 0.f, 0.f};
}

__device__ __forceinline__ void p0_transpose_item(const float* W, int K, int N, bf16* WT, int row_off, LAS float* scr, int item, int lane) {
    const int nblk = N / 32, kb = item / nblk, nb = item % nblk, k0 = 64 * kb, n0 = 32 * nb;
#pragma unroll 8
    for (int i = 0; i < 32; ++i) { const int kk = 2 * i + (lane >> 5); scr[kk * 33 + (lane & 31)] = W[(size_t)(k0 + kk) * N + n0 + (lane & 31)]; }
    LDS_WAIT(); asm volatile("" ::: "memory");
    const int c = lane & 7;
#pragma unroll
    for (int j = 0; j < 4; ++j) { const int n = (lane >> 3) + 8 * j; const LAS float* s = scr + (8 * c) * 33 + n;
        v4u o; o.x = pk2(s[0 * 33], s[1 * 33]); o.y = pk2(s[2 * 33], s[3 * 33]); o.z = pk2(s[4 * 33], s[5 * 33]); o.w = pk2(s[6 * 33], s[7 * 33]);
        *(v4u*)(WT + (size_t)(row_off + n0 + n) * K + k0 + 8 * c) = o; }
    LDS_WAIT(); asm volatile("" ::: "memory");
}

__device__ __forceinline__ void sincos_d(double x, float& s, float& c) {
    const double k = __builtin_rint(x * 0.63661977236758134308);
    double r = __builtin_fma(-k, 1.57079632679489655800e+00, x); r = __builtin_fma(-k, 6.12323399573676603587e-17, r);
    const int q = ((int)k) & 3;
    const float rf = (float)r, z = rf * rf;
    const float sp = rf + rf * z * (-1.6666667163e-01f + z * (8.3333337680e-03f + z * (-1.9841270114e-04f + z * 2.7557314297e-06f)));
    const float cp = 1.0f - 0.5f * z + z * z * (4.1666667908e-02f + z * (-1.3888889225e-03f + z * (2.4801587642e-05f + z * -2.7557314297e-07f)));
    s = (q == 0) ? sp : (q == 1) ? cp : (q == 2) ? -sp : -cp;
    c = (q == 0) ? cp : (q == 1) ? -sp : (q == 2) ? -cp : sp;
}

__device__ __forceinline__ void p0_ssm_group(int g, int tid, LAS unsigned char* lds, const float* log_dt, const float* a_re, const float* a_im,
                                             const float* b_re, const float* b_im, const float* c_re, const float* c_im, bf16* W1, bf16* W2, float* LAM16) {
    LAS float* lp_re = (LAS float*)lds;
    LAS float* lp_im = lp_re + 17 * 64;
    LAS float* bb_re = lp_im + 17 * 64;
    LAS float* bb_im = bb_re + 1024;
    LAS float* cc_re = bb_im + 1024;
    LAS float* cc_im = cc_re + 1024;
    LAS float* ktab = cc_im + 1024;
    __syncthreads();
    const float dt = __expf(log_dt[g]);
    if (tid < 64) {
        const int p = tid; const float a = a_re[g * 64 + p], w = a_im[g * 64 + p];
        for (int tau = 0; tau <= 16; ++tau) { float s, c; sincos_d((double)w * (double)dt * (double)tau, s, c); const float mg = __expf(a * dt * (float)tau);
            lp_re[tau * 64 + p] = mg * c; lp_im[tau * 64 + p] = mg * s; }
        const float lr = lp_re[64 + p], li = lp_im[64 + p];
        const float den = a * a + w * w;
        const float cr = ((lr - 1.0f) * a + li * w) / den, ci = (li * a - (lr - 1.0f) * w) / den;
        for (int h = 0; h < 16; ++h) { const float br = b_re[(g * 64 + p) * 16 + h], bi = b_im[(g * 64 + p) * 16 + h];
            bb_re[p * 16 + h] = cr * br - ci * bi; bb_im[p * 16 + h] = cr * bi + ci * br; }
        LAM16[(g * 64 + p) * 2 + 0] = lp_re[16 * 64 + p]; LAM16[(g * 64 + p) * 2 + 1] = lp_im[16 * 64 + p];
    }
    for (int i = tid; i < 1024; i += NTHR) { cc_re[i] = c_re[g * 1024 + i]; cc_im[i] = c_im[g * 1024 + i]; }
    __syncthreads();
    for (int e = tid; e < 4096; e += NTHR) { const int tau = e >> 8, h = (e >> 4) & 15, hp = e & 15; float acc = 0.f;
        for (int p = 0; p < 64; ++p) { const float lr = lp_re[tau * 64 + p], li = lp_im[tau * 64 + p], br = bb_re[p * 16 + hp], bi = bb_im[p * 16 + hp];
            const float zr = lr * br - li * bi, zi = lr * bi + li * br;
            acc += cc_re[h * 64 + p] * zr - cc_im[h * 64 + p] * zi; }
        ktab[e] = acc; }
    __syncthreads();
    bf16* w1 = W1 + (size_t)g * 128 * 256;
    for (int e = tid; e < 128 * 256; e += NTHR) { const int n = e >> 8, k = e & 255, p = n & 63, j = k >> 4, hp = k & 15, tau = 15 - j;
        const float lr = lp_re[tau * 64 + p], li = lp_im[tau * 64 + p], br = bb_re[p * 16 + hp], bi = bb_im[p * 16 + hp];
        const float v = (n < 64) ? (lr * br - li * bi) : (lr * bi + li * br);
        w1[e] = (bf16)f2bf(v); }
    bf16* w2 = W2 + (size_t)g * 256 * 384;
    for (int e = tid; e < 256 * 384; e += NTHR) { const int n = e / 384, k = e % 384, i = n >> 4, h = n & 15; float v;
        if (k < 256) { const int j = k >> 4, hp = k & 15; v = (j <= i) ? ktab[((i - j) << 8) + (h << 4) + hp] : 0.f; }
        else { const int q = k - 256, p = q & 63, tau = i + 1; const float lr = lp_re[tau * 64 + p], li = lp_im[tau * 64 + p], cr = cc_re[h * 64 + p], ci = cc_im[h * 64 + p];
            v = (q < 64) ? (cr * lr - ci * li) : -(cr * li + ci * lr); }
        w2[e] = (bf16)f2bf(v); }
    __syncthreads();
}

struct Args { const float* in[38]; float* out; unsigned char* ws; int ph_lo, ph_hi; };

constexpr int N_PHASES = 19;

__global__ void __launch_bounds__(NTHR, 2) fwd(Args args) {
    extern __shared__ __attribute__((aligned(16))) unsigned char lds_raw[];
    LAS unsigned char* lds = (LAS unsigned char*)lds_raw;
    volatile LAS unsigned* MISC = (volatile LAS unsigned*)(lds + MISC_OFF);
    const int tid = threadIdx.x, lane = tid & 63, wave = __builtin_amdgcn_readfirstlane(tid >> 6);
    const int G = gridDim.x; const int bx = blockIdx.x; const int vcu = (G % 8 == 0) ? (bx % 8) * (G / 8) + bx / 8 : bx;
    const int gw = vcu * NWAVES + wave, ngw = G * NWAVES;
    const int gtid = vcu * NTHR + tid, ngt = G * NTHR;
    const int fr = lane & 15, fq = lane >> 4;
    unsigned char* ws = args.ws;
    unsigned* ctl = (unsigned*)(ws + WS_CTL);
    for (int u = tid; u < (LDS_BYTES - 131072) / 4; u += NTHR) ((LAS unsigned*)(lds + 131072))[u] = 0u;
    __syncthreads();
#if MK_SPLIT
#define GRID_BAR() do { } while (0)
#else
    XcdBarrier bar = xcd_barrier_post(ctl + CW_BAR, MISC + 8);
#define GRID_BAR() xcd_barrier(bar)
#endif
    const int lo = args.ph_lo, hi = args.ph_hi;
#define IN(k) (lo <= (k) && (k) < hi)
#define BOTH(k) (IN(k) && IN((k) + 1))

    const float* x = args.in[0];
    bf16* XB = (bf16*)(ws + WS_XB); bf16* CV = (bf16*)(ws + WS_CV); bf16* AS = (bf16*)(ws + WS_AS); float* SEND = (float*)(ws + WS_SEND);
    bf16* Z = (bf16*)(ws + WS_Z); float* ZG = (float*)(ws + WS_ZG); bf16* MERGED = (bf16*)(ws + WS_MERGED); float* Y1 = (float*)(ws + WS_Y1);
    float* X1 = (float*)(ws + WS_X1); bf16* X1B = (bf16*)(ws + WS_X1B); bf16* Q = (bf16*)(ws + WS_Q); bf16* O = (bf16*)(ws + WS_O);
    float* X2 = (float*)(ws + WS_X2); bf16* X2B = (bf16*)(ws + WS_X2B); float* LOGITS = (float*)(ws + WS_LOGITS);
    bf16* H = (bf16*)(ws + WS_H); bf16* HS = (bf16*)(ws + WS_HS); bf16* Y = (bf16*)(ws + WS_Y); bf16* YS = (bf16*)(ws + WS_YS);
    bf16* W_IN_T = (bf16*)(ws + WS_W_IN_T); bf16* W_GLU_T = (bf16*)(ws + WS_W_GLU_T); bf16* W_OUT_T = (bf16*)(ws + WS_W_OUT_T);
    bf16* WQ_T = (bf16*)(ws + WS_WQ_T); bf16* WKV_T = (bf16*)(ws + WS_WKV_T); bf16* WO_T = (bf16*)(ws + WS_WO_T); bf16* WR_T = (bf16*)(ws + WS_WR_T);
    bf16* SSM_W1 = (bf16*)(ws + WS_SSM_W1); bf16* SSM_W2 = (bf16*)(ws + WS_SSM_W2); float* LAM16 = (float*)(ws + WS_LAM16);
    bf16* SH_GU_T = (bf16*)(ws + WS_SH_GU_T); bf16* SH_D_T = (bf16*)(ws + WS_SH_D_T);
    bf16* MEMB = (bf16*)(ws + WS_MEMB); bf16* KB = (bf16*)(ws + WS_KB); bf16* VT = (bf16*)(ws + WS_VT);
    bf16* WGU_T = (bf16*)(ws + WS_WGU_T); bf16* WD_T = (bf16*)(ws + WS_WD_T);
    int* TOPE = (int*)(ws + WS_TOPE); int* TOPP = (int*)(ws + WS_TOPP); float* GATE = (float*)(ws + WS_GATE); int* SLOT = (int*)(ws + WS_SLOT);
    int* STOK = (int*)(ws + WS_STOK); float* SGATE = (float*)(ws + WS_SGATE);
    unsigned* CNT = ctl + CW_CNT;

    if (IN(0)) {
        LAS float* scr = (LAS float*)(lds + wave * 16384);
        constexpr int I_SMALL = 768 + 128 + 512 * 4 + 512 + 128 * 4;
        constexpr int NITEMS = I_SMALL + NE * 384;
        for (int it = gw; it < NITEMS; it += ngw) {
            int r = it;
            if (r >= I_SMALL) { r -= I_SMALL; const int e = r / 384, q = r % 384;
                if (q < 128) p0_transpose_item(args.in[30] + (size_t)e * D * DE, D, DE, WGU_T + (size_t)e * 512 * D, 0, scr, q, lane);
                else if (q < 256) p0_transpose_item(args.in[31] + (size_t)e * D * DE, D, DE, WGU_T + (size_t)e * 512 * D, 256, scr, q - 128, lane);
                else p0_transpose_item(args.in[32] + (size_t)e * DE * D, DE, D, WD_T + (size_t)e * D * DE, 0, scr, q - 256, lane);
                continue; }
            if (r < 768) { p0_transpose_item(args.in[2], D, 1536, W_IN_T, 0, scr, r, lane); continue; } r -= 768;
            if (r < 128) { p0_transpose_item(args.in[15], 512, 512, W_GLU_T, 0, scr, r, lane); continue; } r -= 128;
            if (r < 512) { p0_transpose_item(args.in[19], D, D, W_OUT_T, 0, scr, r, lane); continue; } r -= 512;
            if (r < 512) { p0_transpose_item(args.in[22], D, D, WQ_T, 0, scr, r, lane); continue; } r -= 512;
            if (r < 512) { p0_transpose_item(args.in[23], D, D, WKV_T, 0, scr, r, lane); continue; } r -= 512;
            if (r < 512) { p0_transpose_item(args.in[24], D, D, WKV_T, 1024, scr, r, lane); continue; } r -= 512;
            if (r < 512) { p0_transpose_item(args.in[25], D, D, WO_T, 0, scr, r, lane); continue; } r -= 512;
            if (r < 128) { p0_transpose_item(args.in[28], D, 256, WR_T, 0, scr, r, lane); continue; } r -= 128;
            if (r < 128) { p0_transpose_item(args.in[33], D, 256, SH_GU_T, 0, scr, r, lane); continue; } r -= 128;
            if (r < 128) { p0_transpose_item(args.in[34], D, 256, SH_GU_T, 256, scr, r, lane); continue; } r -= 128;
            p0_transpose_item(args.in[35], 256, D, SH_D_T, 0, scr, r, lane);
        }
        for (size_t i = (size_t)gtid * 8; i < (size_t)T * D; i += (size_t)ngt * 8) { const f32x4 a = *(const f32x4*)(x + i), b = *(const f32x4*)(x + i + 4);
            v4u o; o.x = pk2(a[0], a[1]); o.y = pk2(a[2], a[3]); o.z = pk2(b[0], b[1]); o.w = pk2(b[2], b[3]); *(v4u*)(XB + i) = o; }
        for (size_t i = (size_t)gtid * 8; i < (size_t)NB * MEML * D; i += (size_t)ngt * 8) { const f32x4 a = *(const f32x4*)(args.in[1] + i), b = *(const f32x4*)(args.in[1] + i + 4);
            v4u o; o.x = pk2(a[0], a[1]); o.y = pk2(a[2], a[3]); o.z = pk2(b[0], b[1]); o.w = pk2(b[2], b[3]); *(v4u*)(MEMB + i) = o; }
        __syncthreads();
        for (int g = vcu; g < NG; g += G)
            p0_ssm_group(g, tid, lds, args.in[7], args.in[8], args.in[9], args.in[10], args.in[11], args.in[12], args.in[13], SSM_W1, SSM_W2, LAM16);
        if (BOTH(0)) GRID_BAR();
    }

    if (IN(1)) {
        constexpr int NT1 = 1536 / 64, TILES1 = (T / 64) * NT1, NT2 = 2048 / 64, TILES2 = (NB * MEML / 64) * NT2;
        for (int t = gw; t < TILES1 + TILES2; t += ngw) {
            const bool kv = t >= TILES1; const int tt = kv ? t - TILES1 : t;
            const int mt = kv ? tt / NT2 : tt / NT1, nt = kv ? tt % NT2 : tt % NT1, m0 = mt * 64, n0 = nt * 64;
            const bf16* A = kv ? MEMB : XB; const bf16* Bt = kv ? WKV_T : W_IN_T;
            const bf16* ar[4]; const bf16* br[4];
#pragma unroll
            for (int i = 0; i < 4; ++i) { ar[i] = A + (size_t)(m0 + 16 * i + fr) * D + fq * 8; br[i] = Bt + (size_t)(n0 + 16 * i + fr) * D + fq * 8; }
            f32x4 acc[4][4]; zero_acc(acc);
            wave_mma<4, 4>(ar, br, D, acc);
#pragma unroll
            for (int i = 0; i < 4; ++i)
#pragma unroll
                for (int j = 0; j < 4; ++j) { const int m = m0 + 16 * i + fr, n = n0 + 16 * j + 4 * fq; const f32x4 v = acc[i][j];
                    if (!kv) { v2u w; w.x = pk2(v[0], v[1]); w.y = pk2(v[2], v[3]);
                        if (n0 < 1024) *(v2u*)(CV + (size_t)m * 1024 + n) = w;
                        else { const int ch = n - 1024, g = ch >> 4, h = ch & 15; *(v2u*)(AS + ((size_t)(g * NCH + (m >> 4)) * 384 + (m & 15) * 16 + h)) = w; } }
                    else { if (n0 < 1024) { v2u w; w.x = pk2(v[0], v[1]); w.y = pk2(v[2], v[3]); *(v2u*)(KB + (size_t)m * 1024 + n) = w; }
                        else { const int d = n - 1024, b = m >> 8, key = m & 255;
#pragma unroll
                            for (int r = 0; r < 4; ++r) VT[((size_t)(b * 1024 + d + r)) * 256 + key] = (bf16)f2bf(v[r]); } } }
        }
        if (BOTH(1)) GRID_BAR();
    }

    if (IN(2)) {
        {
            LAS float* yl = (LAS float*)lds;
            const int c = tid;
            float wk[CW];
#pragma unroll
            for (int k = 0; k < CW; ++k) wk[k] = args.in[3][k * DC + c];
            const float cb = args.in[4][c];
            for (int u = vcu; u < T / 32; u += G) {
                const int t0 = u * 32, tl0 = t0 & (SEQ - 1);
                float win[CW];
#pragma unroll
                for (int k = 0; k < CW; ++k) win[k] = 0.f;
                for (int tt = -30; tt < 32; ++tt) {
                    float hv = 0.f;
                    if (tl0 + tt >= 0) { const size_t o = (size_t)(t0 + tt) * 1024 + c; const float v = bf2f(CV[o]), gt = bf2f(CV[o + 512]); hv = v * sigmoidf_(gt); }
#pragma unroll
                    for (int k = 0; k < CW - 1; ++k) win[k] = win[k + 1];
                    win[CW - 1] = hv;
                    if (tt >= 0) { float a = cb;
#pragma unroll
                        for (int k = 0; k < CW; ++k) a += wk[k] * win[k];
                        yl[tt * 512 + c] = a; }
                }
                __syncthreads();
                for (int r = wave; r < 32; r += NWAVES) {
                    float v[8]; float s = 0.f;
#pragma unroll
                    for (int j = 0; j < 8; ++j) { v[j] = yl[r * 512 + lane + 64 * j]; s += v[j]; }
                    const float mean = wave_sum(s) * (1.0f / 512.0f); float s2 = 0.f;
#pragma unroll
                    for (int j = 0; j < 8; ++j) { v[j] -= mean; s2 += v[j] * v[j]; }
                    const float rstd = 1.0f / sqrtf(wave_sum(s2) * (1.0f / 512.0f) + EPS); float s3 = 0.f;
#pragma unroll
                    for (int j = 0; j < 8; ++j) { const int cc = lane + 64 * j; float y = v[j] * rstd * args.in[5][cc] + args.in[6][cc]; y = y * sigmoidf_(y); v[j] = y; s3 += y * y; }
                    const float rr = 1.0f / sqrtf(wave_sum(s3) * (1.0f / 512.0f) + EPS);
#pragma unroll
                    for (int j = 0; j < 8; ++j) { const int cc = lane + 64 * j; MERGED[(size_t)(t0 + r) * 1024 + cc] = (bf16)f2bf(v[j] * rr * args.in[17][cc]); }
                }
                __syncthreads();
            }
        }
        {
            constexpr int TPG = (NCH / 64) * 2, TILES = NG * TPG;
            for (int t = gw; t < TILES; t += ngw) {
                const int g = t / TPG, q = t % TPG, m0 = (q >> 1) * 64, n0 = (q & 1) * 64;
                const bf16* ar[4]; const bf16* br[4];
#pragma unroll
                for (int i = 0; i < 4; ++i) { ar[i] = AS + ((size_t)(g * NCH + m0 + 16 * i + fr)) * 384 + fq * 8; br[i] = SSM_W1 + ((size_t)(g * 128 + n0 + 16 * i + fr)) * 256 + fq * 8; }
                f32x4 acc[4][4]; zero_acc(acc);
                wave_mma<4, 4>(ar, br, 256, acc);
#pragma unroll
                for (int i = 0; i < 4; ++i)
#pragma unroll
                    for (int j = 0; j < 4; ++j) *(f32x4*)(SEND + ((size_t)(g * NCH + m0 + 16 * i + fr)) * 128 + n0 + 16 * j + 4 * fq) = acc[i][j];
            }
        }
        if (BOTH(2)) GRID_BAR();
    }

    if (IN(3)) {
        if (gw < NG * NB) {
            const int g = gw >> 2, b = gw & 3, p = lane;
            const float lr = LAM16[(g * 64 + p) * 2], li = LAM16[(g * 64 + p) * 2 + 1];
            float sr = 0.f, si = 0.f;
            for (int c0 = 0; c0 < SEQ / LC; c0 += 8) {
                float er[8], ei[8];
#pragma unroll
                for (int q = 0; q < 8; ++q) { const size_t o = ((size_t)(g * NCH + b * 256 + c0 + q)) * 128 + p; er[q] = SEND[o]; ei[q] = SEND[o + 64]; }
#pragma unroll
                for (int q = 0; q < 8; ++q) { const size_t o = ((size_t)(g * NCH + b * 256 + c0 + q)) * 384 + 256 + p;
                    AS[o] = (bf16)f2bf(sr); AS[o + 64] = (bf16)f2bf(si);
                    const float nr = lr * sr - li * si + er[q], ni = lr * si + li * sr + ei[q]; sr = nr; si = ni; }
            }
        }
        if (BOTH(3)) GRID_BAR();
    }

    if (IN(4)) {
        constexpr int TPG = (NCH / 64) * 4, TILES = NG * TPG;
        for (int t = gw; t < TILES; t += ngw) {
            const int g = t / TPG, q = t % TPG, m0 = (q >> 2) * 64, n0 = (q & 3) * 64;
            const bf16* ar[4]; const bf16* br[4];
#pragma unroll
            for (int i = 0; i < 4; ++i) { ar[i] = AS + ((size_t)(g * NCH + m0 + 16 * i + fr)) * 384 + fq * 8; br[i] = SSM_W2 + ((size_t)(g * 256 + n0 + 16 * i + fr)) * 384 + fq * 8; }
            f32x4 acc[4][4]; zero_acc(acc);
            wave_mma<4, 4>(ar, br, 384, acc);
#pragma unroll
            for (int i = 0; i < 4; ++i)
#pragma unroll
                for (int j = 0; j < 4; ++j) { const int r = m0 + 16 * i + fr, n = n0 + 16 * j + 4 * fq, ti = n >> 4, h = n & 15;
                    const v2u uu = *(const v2u*)(AS + ((size_t)(g * NCH + r)) * 384 + n);
                    const f32x4 dd = *(const f32x4*)(args.in[14] + g * 16 + h);
                    const float y0 = acc[i][j][0] + dd[0] * bflo(uu.x), y1 = acc[i][j][1] + dd[1] * bfhi(uu.x), y2 = acc[i][j][2] + dd[2] * bflo(uu.y), y3 = acc[i][j][3] + dd[3] * bfhi(uu.y);
                    v2u w; w.x = pk2(gelu_tanh(y0), gelu_tanh(y1)); w.y = pk2(gelu_tanh(y2), gelu_tanh(y3));
                    *(v2u*)(Z + ((size_t)(r * 16 + ti)) * 512 + g * 16 + h) = w; }
        }
        if (BOTH(4)) GRID_BAR();
    }

    if (IN(5)) {
        constexpr int NT = 512 / 64, TILES = (T / 64) * NT;
        for (int t = gw; t < TILES; t += ngw) {
            const int m0 = (t / NT) * 64, n0 = (t % NT) * 64;
            const bf16* ar[4]; const bf16* br[4];
#pragma unroll
            for (int i = 0; i < 4; ++i) { ar[i] = Z + (size_t)(m0 + 16 * i + fr) * 512 + fq * 8; br[i] = W_GLU_T + (size_t)(n0 + 16 * i + fr) * 512 + fq * 8; }
            f32x4 acc[4][4]; zero_acc(acc);
            wave_mma<4, 4>(ar, br, 512, acc);
#pragma unroll
            for (int i = 0; i < 4; ++i)
#pragma unroll
                for (int j = 0; j < 4; ++j) { const int m = m0 + 16 * i + fr, n = n0 + 16 * j + 4 * fq;
                    const v2u zz = *(const v2u*)(Z + (size_t)m * 512 + n); const f32x4 bg = *(const f32x4*)(args.in[16] + n);
                    f32x4 o; o[0] = bflo(zz.x) * sigmoidf_(acc[i][j][0] + bg[0]); o[1] = bfhi(zz.x) * sigmoidf_(acc[i][j][1] + bg[1]);
                    o[2] = bflo(zz.y) * sigmoidf_(acc[i][j][2] + bg[2]); o[3] = bfhi(zz.y) * sigmoidf_(acc[i][j][3] + bg[3]);
                    *(f32x4*)(ZG + (size_t)m * 512 + n) = o; }
        }
        if (BOTH(5)) GRID_BAR();
    }

    if (IN(6)) {
        for (int m = gw; m < T; m += ngw) {
            const f32x4 a = *(const f32x4*)(ZG + (size_t)m * 512 + lane * 4), b = *(const f32x4*)(ZG + (size_t)m * 512 + 256 + lane * 4);
            float s = (a[0] * a[0] + a[1] * a[1]) + (a[2] * a[2] + a[3] * a[3]) + (b[0] * b[0] + b[1] * b[1]) + (b[2] * b[2] + b[3] * b[3]);
            const float rr = 1.0f / sqrtf(wave_sum(s) * (1.0f / 512.0f) + EPS);
            const f32x4 ga = *(const f32x4*)(args.in[18] + lane * 4), gb = *(const f32x4*)(args.in[18] + 256 + lane * 4);
            v2u w; w.x = pk2(a[0] * rr * ga[0], a[1] * rr * ga[1]); w.y = pk2(a[2] * rr * ga[2], a[3] * rr * ga[3]);
            *(v2u*)(MERGED + (size_t)m * 1024 + 512 + lane * 4) = w;
            w.x = pk2(b[0] * rr * gb[0], b[1] * rr * gb[1]); w.y = pk2(b[2] * rr * gb[2], b[3] * rr * gb[3]);
            *(v2u*)(MERGED + (size_t)m * 1024 + 768 + lane * 4) = w;
        }
        if (BOTH(6)) GRID_BAR();
    }

#define GEMM_D_D(Aptr, Btptr, ...) do { \
        constexpr int NT = D / 64, TILES = (T / 64) * NT; \
        for (int t = gw; t < TILES; t += ngw) { \
            const int m0 = (t / NT) * 64, n0 = (t % NT) * 64; \
            const bf16* ar[4]; const bf16* br[4]; \
            _Pragma("unroll") for (int i = 0; i < 4; ++i) { ar[i] = (Aptr) + (size_t)(m0 + 16 * i + fr) * D + fq * 8; br[i] = (Btptr) + (size_t)(n0 + 16 * i + fr) * D + fq * 8; } \
            f32x4 acc[4][4]; zero_acc(acc); \
            wave_mma<4, 4>(ar, br, D, acc); \
            _Pragma("unroll") for (int i = 0; i < 4; ++i) _Pragma("unroll") for (int j = 0; j < 4; ++j) { const int m = m0 + 16 * i + fr, n = n0 + 16 * j + 4 * fq; const f32x4 v = acc[i][j]; __VA_ARGS__ } \
        } } while (0)

#define LN_ROWS(SRC, GAIN, BIAS, DSTF, DSTB) do { \
        for (int m = gw; m < T; m += ngw) { \
            f32x4 v[4]; float s = 0.f; \
            _Pragma("unroll") for (int j = 0; j < 4; ++j) { v[j] = *(const f32x4*)((SRC) + (size_t)m * D + j * 256 + lane * 4); s += (v[j][0] + v[j][1]) + (v[j][2] + v[j][3]); } \
            const float mean = wave_sum(s) * (1.0f / D); float s2 = 0.f; \
            _Pragma("unroll") for (int j = 0; j < 4; ++j) { v[j] = v[j] - mean; s2 += (v[j][0] * v[j][0] + v[j][1] * v[j][1]) + (v[j][2] * v[j][2] + v[j][3] * v[j][3]); } \
            const float rstd = 1.0f / sqrtf(wave_sum(s2) * (1.0f / D) + EPS); \
            _Pragma("unroll") for (int j = 0; j < 4; ++j) { const f32x4 gg = *(const f32x4*)((GAIN) + j * 256 + lane * 4), bb = *(const f32x4*)((BIAS) + j * 256 + lane * 4); \
                const f32x4 o = v[j] * rstd * gg + bb; *(f32x4*)((DSTF) + (size_t)m * D + j * 256 + lane * 4) = o; \
                if ((DSTB) != nullptr) { v2u w; w.x = pk2(o[0], o[1]); w.y = pk2(o[2], o[3]); *(v2u*)((DSTB) + (size_t)m * D + j * 256 + lane * 4) = w; } } \
        } } while (0)

    if (IN(7)) {
        GEMM_D_D(MERGED, W_OUT_T, { const f32x4 xr = *(const f32x4*)(x + (size_t)m * D + n); *(f32x4*)(Y1 + (size_t)m * D + n) = xr * ALPHA + v; });
        if (BOTH(7)) GRID_BAR();
    }
    if (IN(8)) {
        LN_ROWS(Y1, args.in[20], args.in[21], X1, X1B);
        if (BOTH(8)) GRID_BAR();
    }
    if (IN(9)) {
        GEMM_D_D(X1B, WQ_T, { v2u w; w.x = pk2(v[0] * 0.0625f, v[1] * 0.0625f); w.y = pk2(v[2] * 0.0625f, v[3] * 0.0625f); *(v2u*)(Q + (size_t)m * D + n) = w; });
        if (BOTH(9)) GRID_BAR();
    }
    if (IN(10)) {
        for (int u = gw; u < NB * NXH * (SEQ / 16); u += ngw) {
            const int bh = u / (SEQ / 16), qt = u % (SEQ / 16), b = bh >> 2, h = bh & 3;
            const bf16* qrow = Q + (size_t)(b * SEQ + qt * 16 + fr) * D + h * XHD + fq * 8;
            bf16x8 qf[8];
#pragma unroll
            for (int ks = 0; ks < 8; ++ks) qf[ks] = *(const bf16x8*)(qrow + ks * 32);
            f32x4 s[16];
#pragma unroll
            for (int nt = 0; nt < 16; ++nt) { s[nt] = (f32x4){0.f, 0.f, 0.f, 0.f};
                const bf16* krow = KB + (size_t)(b * MEML + nt * 16 + fr) * D + h * XHD + fq * 8;
#pragma unroll
                for (int ks = 0; ks < 8; ++ks) { const bf16x8 kf = *(const bf16x8*)(krow + ks * 32); s[nt] = __builtin_amdgcn_mfma_f32_16x16x32_bf16(kf, qf[ks], s[nt], 0, 0, 0); } }
            float mx = -3.0e38f;
#pragma unroll
            for (int nt = 0; nt < 16; ++nt) mx = fmaxf(mx, fmaxf(fmaxf(s[nt][0], s[nt][1]), fmaxf(s[nt][2], s[nt][3])));
            mx = fmaxf(mx, __shfl_xor(mx, 16)); mx = fmaxf(mx, __shfl_xor(mx, 32));
            float sum = 0.f;
#pragma unroll
            for (int nt = 0; nt < 16; ++nt) {
#pragma unroll
                for (int r = 0; r < 4; ++r) { const float e = __expf(s[nt][r] - mx); s[nt][r] = e; sum += e; } }
            sum += __shfl_xor(sum, 16); sum += __shfl_xor(sum, 32);
            const float inv = 1.0f / sum;
            bf16x8 pf[8];
#pragma unroll
            for (int ks = 0; ks < 8; ++ks) { v4u w; w.x = pk2(s[2 * ks][0] * inv, s[2 * ks][1] * inv); w.y = pk2(s[2 * ks][2] * inv, s[2 * ks][3] * inv);
                w.z = pk2(s[2 * ks + 1][0] * inv, s[2 * ks + 1][1] * inv); w.w = pk2(s[2 * ks + 1][2] * inv, s[2 * ks + 1][3] * inv); pf[ks] = __builtin_bit_cast(bf16x8, w); }
            bf16* orow = O + (size_t)(b * SEQ + qt * 16 + fr) * D + h * XHD + 4 * fq;
#pragma unroll
            for (int dt = 0; dt < 16; ++dt) { f32x4 o = (f32x4){0.f, 0.f, 0.f, 0.f};
                const bf16* vrow = VT + ((size_t)(b * 1024 + h * XHD + dt * 16 + fr)) * 256 + 4 * fq;
#pragma unroll
                for (int ks = 0; ks < 8; ++ks) { const v2u lo2 = *(const v2u*)(vrow + ks * 32), hi2 = *(const v2u*)(vrow + ks * 32 + 16);
                    v4u w; w.x = lo2.x; w.y = lo2.y; w.z = hi2.x; w.w = hi2.y;
                    o = __builtin_amdgcn_mfma_f32_16x16x32_bf16(__builtin_bit_cast(bf16x8, w), pf[ks], o, 0, 0, 0); }
                v2u w; w.x = pk2(o[0], o[1]); w.y = pk2(o[2], o[3]); *(v2u*)(orow + dt * 16) = w; }
        }
        if (BOTH(10)) GRID_BAR();
    }
    if (IN(11)) {
        GEMM_D_D(O, WO_T, { const f32x4 xr = *(const f32x4*)(X1 + (size_t)m * D + n); *(f32x4*)(Y1 + (size_t)m * D + n) = xr * ALPHA + v; });
        if (BOTH(11)) GRID_BAR();
    }
    if (IN(12)) {
        LN_ROWS(Y1, args.in[26], args.in[27], X2, X2B);
        if (BOTH(12)) GRID_BAR();
    }
    if (IN(13)) {
        constexpr int NT = NE / 64, TILES = (T / 64) * NT;
        for (int t = gw; t < TILES; t += ngw) {
            const int m0 = (t / NT) * 64, n0 = (t % NT) * 64;
            const bf16* ar[4]; const bf16* br[4];
#pragma unroll
            for (int i = 0; i < 4; ++i) { ar[i] = X2B + (size_t)(m0 + 16 * i + fr) * D + fq * 8; br[i] = WR_T + (size_t)(n0 + 16 * i + fr) * D + fq * 8; }
            f32x4 acc[4][4]; zero_acc(acc);
            wave_mma<4, 4>(ar, br, D, acc);
#pragma unroll
            for (int i = 0; i < 4; ++i)
#pragma unroll
                for (int j = 0; j < 4; ++j) *(f32x4*)(LOGITS + (size_t)(m0 + 16 * i + fr) * NE + n0 + 16 * j + 4 * fq) = acc[i][j];
        }
        if (BOTH(13)) GRID_BAR();
    }
    if (IN(14)) {
        const f32x4 rb = *(const f32x4*)(args.in[29] + lane * 4);
        for (int m = gw; m < T; m += ngw) {
            const f32x4 lg = *(const f32x4*)(LOGITS + (size_t)m * NE + lane * 4);
            float sc[4], bs[4];
#pragma unroll
            for (int r = 0; r < 4; ++r) { sc[r] = sigmoidf_(lg[r]); bs[r] = sc[r] + rb[r]; }
            float m1 = fmaxf(bs[0], bs[1]), m2 = fminf(bs[0], bs[1]);
            { const float a = bs[2]; const float n1 = fmaxf(m1, a); m2 = fmaxf(m2, fminf(m1, a)); m1 = n1; }
            { const float a = bs[3]; const float n1 = fmaxf(m1, a); m2 = fmaxf(m2, fminf(m1, a)); m1 = n1; }
#pragma unroll
            for (int o = 1; o < 8; o <<= 1) { const float o1 = __shfl_xor(m1, o), o2 = __shfl_xor(m2, o); const float n1 = fmaxf(m1, o1); m2 = fmaxf(fminf(m1, o1), fmaxf(m2, o2)); m1 = n1; }
            const float gs = m1 + m2; const int myg = lane >> 3;
            int rank = 0;
#pragma unroll
            for (int g2 = 0; g2 < 8; ++g2) { const float og = __shfl(gs, g2 * 8); rank += (og > gs || (og == gs && g2 < myg)) ? 1 : 0; }
            const bool sel = rank < TKG;
            float mv[4];
#pragma unroll
            for (int r = 0; r < 4; ++r) mv[r] = sel ? bs[r] : -3.0e38f;
            int my_e = 0; float my_sc = 0.f; float gsum = 0.f;
#pragma unroll
            for (int k = 0; k < TOPK; ++k) {
                float bv = mv[0]; int bi = 0;
#pragma unroll
                for (int r = 1; r < 4; ++r) if (mv[r] > bv) { bv = mv[r]; bi = r; }
                int be = lane * 4 + bi;
#pragma unroll
                for (int o = 1; o < 64; o <<= 1) { const float ov = __shfl_xor(bv, o); const int oe = __shfl_xor(be, o); if (ov > bv || (ov == bv && oe < be)) { bv = ov; be = oe; } }
                const int wl = be >> 2, wr_ = be & 3;
                float wsc = (wr_ == 0) ? sc[0] : (wr_ == 1) ? sc[1] : (wr_ == 2) ? sc[2] : sc[3];
                wsc = __shfl(wsc, wl);
                if (lane == wl) {
#pragma unroll
                    for (int r = 0; r < 4; ++r) if (r == wr_) mv[r] = -3.0e38f; }
                gsum += wsc;
                if (lane == k) { my_e = be; my_sc = wsc; }
            }
            if (lane < TOPK) { const unsigned pos = __hip_atomic_fetch_add(CNT + my_e, 1u, RLX_AGENT);
                TOPE[m * 8 + lane] = my_e; TOPP[m * 8 + lane] = (int)pos; GATE[m * 8 + lane] = ROUTED_SCALE * my_sc / gsum; }
        }
        if (BOTH(14)) GRID_BAR();
    }
#define MOE_OFFSETS() LAS int* off = (LAS int*)lds; LAS int* tst = off + 260; \
        __syncthreads(); \
        if (tid < 64) { int c4[4]; int s = 0, s2 = 0; \
            _Pragma("unroll") for (int r = 0; r < 4; ++r) { c4[r] = (int)__hip_atomic_load(CNT + tid * 4 + r, RLX_AGENT); s += c4[r]; s2 += (c4[r] + 63) >> 6; } \
            int ps = s, ps2 = s2; \
            _Pragma("unroll") for (int o = 1; o < 64; o <<= 1) { const int a = __shfl_up(ps, o), a2 = __shfl_up(ps2, o); if (lane >= o) { ps += a; ps2 += a2; } } \
            int e0 = ps - s, t0 = ps2 - s2; \
            _Pragma("unroll") for (int r = 0; r < 4; ++r) { off[tid * 4 + r] = e0; tst[tid * 4 + r] = t0; e0 += c4[r]; t0 += (c4[r] + 63) >> 6; } \
            if (tid == 63) { off[256] = e0; tst[256] = t0; } } \
        __syncthreads();

    if (IN(15)) {
        MOE_OFFSETS();
        for (int a = gtid; a < NASSIGN; a += ngt) { const int e = TOPE[a], sl = off[e] + TOPP[a]; SLOT[a] = sl; STOK[sl] = a >> 3; SGATE[sl] = GATE[a]; }
        if (BOTH(15)) GRID_BAR();
    }
    if (IN(16)) {
        MOE_OFFSETS();
        const int nmt_moe = tst[256], nmt = nmt_moe + T / 64;
        for (int t = gw; t < nmt * 8; t += ngw) {
            const int mtg = t >> 3, nb = t & 7; const bool shared = mtg >= nmt_moe;
            int e = 0, row0 = 0, cnt = 64, base = 0;
            if (!shared) { int lo_ = 0, hi_ = 256; while (hi_ - lo_ > 1) { const int mid = (lo_ + hi_) >> 1; if (tst[mid] <= mtg) lo_ = mid; else hi_ = mid; } e = lo_;
                base = off[e]; row0 = (mtg - tst[e]) * 64; cnt = off[e + 1] - base - row0; }
            else { row0 = (mtg - nmt_moe) * 64; }
            const bf16* Bt = shared ? SH_GU_T : WGU_T + (size_t)e * 512 * D;
            const bf16* ar[4]; const bf16* br[4];
#pragma unroll
            for (int i = 0; i < 4; ++i) { const int rl = 16 * i + fr; int tok;
                if (shared) tok = row0 + rl; else tok = STOK[base + row0 + (rl < cnt ? rl : 0)];
                ar[i] = X2B + (size_t)tok * D + fq * 8; }
#pragma unroll
            for (int j = 0; j < 2; ++j) { br[j] = Bt + (size_t)(nb * 32 + 16 * j + fr) * D + fq * 8; br[j + 2] = Bt + (size_t)(256 + nb * 32 + 16 * j + fr) * D + fq * 8; }
            f32x4 acc[4][4]; zero_acc(acc);
            wave_mma<4, 4>(ar, br, D, acc);
#pragma unroll
            for (int i = 0; i < 4; ++i) { const int rl = 16 * i + fr;
                if (rl < cnt) { bf16* hrow = shared ? HS + (size_t)(row0 + rl) * DE : H + (size_t)(base + row0 + rl) * DE;
#pragma unroll
                    for (int j = 0; j < 2; ++j) { const f32x4 gt = acc[i][j], up = acc[i][j + 2]; float hv[4];
#pragma unroll
                        for (int r = 0; r < 4; ++r) hv[r] = gt[r] * sigmoidf_(gt[r]) * up[r];
                        v2u w; w.x = pk2(hv[0], hv[1]); w.y = pk2(hv[2], hv[3]); *(v2u*)(hrow + nb * 32 + 16 * j + 4 * fq) = w; } } }
        }
        if (BOTH(16)) GRID_BAR();
    }
    if (IN(17)) {
        MOE_OFFSETS();
        const int nmt_moe = tst[256], nmt = nmt_moe + T / 64;
        for (int t = gw; t < nmt * 16; t += ngw) {
            const int mtg = t >> 4, nb = t & 15; const bool shared = mtg >= nmt_moe;
            int e = 0, row0 = 0, cnt = 64, base = 0;
            if (!shared) { int lo_ = 0, hi_ = 256; while (hi_ - lo_ > 1) { const int mid = (lo_ + hi_) >> 1; if (tst[mid] <= mtg) lo_ = mid; else hi_ = mid; } e = lo_;
                base = off[e]; row0 = (mtg - tst[e]) * 64; cnt = off[e + 1] - base - row0; }
            else { row0 = (mtg - nmt_moe) * 64; }
            const bf16* Bt = shared ? SH_D_T : WD_T + (size_t)e * D * DE;
            const bf16* ar[4]; const bf16* br[4];
#pragma unroll
            for (int i = 0; i < 4; ++i) { const int rl = 16 * i + fr; const int rr = (rl < cnt ? rl : 0);
                ar[i] = (shared ? HS + (size_t)(row0 + rr) * DE : H + (size_t)(base + row0 + rr) * DE) + fq * 8;
                br[i] = Bt + (size_t)(nb * 64 + 16 * i + fr) * DE + fq * 8; }
            f32x4 acc[4][4]; zero_acc(acc);
            wave_mma<4, 4>(ar, br, DE, acc);
#pragma unroll
            for (int i = 0; i < 4; ++i) { const int rl = 16 * i + fr;
                if (rl < cnt) { const float gt = shared ? 1.0f : SGATE[base + row0 + rl];
                    bf16* yrow = shared ? YS + (size_t)(row0 + rl) * D : Y + (size_t)(base + row0 + rl) * D;
#pragma unroll
                    for (int j = 0; j < 4; ++j) { const f32x4 v = acc[i][j] * gt; v2u w; w.x = pk2(v[0], v[1]); w.y = pk2(v[2], v[3]); *(v2u*)(yrow + nb * 64 + 16 * j + 4 * fq) = w; } } }
        }
        if (BOTH(17)) GRID_BAR();
    }
    if (IN(18)) {
        for (int m = gw; m < T; m += ngw) {
            f32x4 v[4];
#pragma unroll
            for (int j = 0; j < 4; ++j) { v[j] = *(const f32x4*)(X2 + (size_t)m * D + j * 256 + lane * 4) * ALPHA;
                const v2u ys = *(const v2u*)(YS + (size_t)m * D + j * 256 + lane * 4); v[j][0] += bflo(ys.x); v[j][1] += bfhi(ys.x); v[j][2] += bflo(ys.y); v[j][3] += bfhi(ys.y); }
#pragma unroll
            for (int k = 0; k < TOPK; ++k) { const int sl = SLOT[m * 8 + k];
#pragma unroll
                for (int j = 0; j < 4; ++j) { const v2u yy = *(const v2u*)(Y + (size_t)sl * D + j * 256 + lane * 4); v[j][0] += bflo(yy.x); v[j][1] += bfhi(yy.x); v[j][2] += bflo(yy.y); v[j][3] += bfhi(yy.y); } }
            float s = 0.f;
#pragma unroll
            for (int j = 0; j < 4; ++j) s += (v[j][0] + v[j][1]) + (v[j][2] + v[j][3]);
            const float mean = wave_sum(s) * (1.0f / D); float s2 = 0.f;
#pragma unroll
            for (int j = 0; j < 4; ++j) { v[j] = v[j] - mean; s2 += (v[j][0] * v[j][0] + v[j][1] * v[j][1]) + (v[j][2] * v[j][2] + v[j][3] * v[j][3]); }
            const float rstd = 1.0f / sqrtf(wave_sum(s2) * (1.0f / D) + EPS);
#pragma unroll
            for (int j = 0; j < 4; ++j) { const f32x4 gg = *(const f32x4*)(args.in[36] + j * 256 + lane * 4), bb = *(const f32x4*)(args.in[37] + j * 256 + lane * 4);
                *(f32x4*)(args.out + (size_t)m * D + j * 256 + lane * 4) = v[j] * rstd * gg + bb; }
        }
    }
#undef IN
#undef BOTH
}

extern "C" void kernel_launch(void* const* d_in, const int* in_sizes, int n_in, void* d_out, int out_size, void* d_ws, size_t ws_size, hipStream_t stream) {
    static int grid = 0;
    if (grid == 0) {
        if (n_in != 38 || out_size != T * D || ws_size < WS_END) { fprintf(stderr, "kernel_launch: unexpected shapes (n_in %d, out %d, ws %zu)\n", n_in, out_size, ws_size); grid = -1; return; }
        int dev = 0, cus = 0, per_cu = 0;
        if (hipGetDevice(&dev) != hipSuccess || hipDeviceGetAttribute(&cus, hipDeviceAttributeMultiprocessorCount, dev) != hipSuccess) { grid = -1; return; }
        if (hipFuncSetAttribute((const void*)fwd, hipFuncAttributeMaxDynamicSharedMemorySize, LDS_BYTES) != hipSuccess) { fprintf(stderr, "kernel_launch: hipFuncSetAttribute failed\n"); grid = -1; return; }
        if (hipOccupancyMaxActiveBlocksPerMultiprocessor(&per_cu, (const void*)fwd, NTHR, LDS_BYTES) != hipSuccess || per_cu < 1) { fprintf(stderr, "kernel_launch: occupancy query says %d\n", per_cu); }
        (void)hipGetLastError();
        grid = cus;
    }
    if (grid < 0) return;
    (void)hipMemsetAsync((char*)d_ws + WS_CTL, 0, CTL_ZERO_BYTES, stream);
    Args a{};
    for (int i = 0; i < 38; ++i) a.in[i] = (const float*)d_in[i];
    a.out = (float*)d_out; a.ws = (unsigned char*)d_ws;
#if MK_SPLIT
    for (int p = 0; p < N_PHASES; ++p) { a.ph_lo = p; a.ph_hi = p + 1; hipLaunchKernelGGL(fwd, dim3(grid), dim3(NTHR), LDS_BYTES, stream, a); }
#else
    a.ph_lo = 0; a.ph_hi = N_PHASES;
    hipLaunchKernelGGL(fwd, dim3(grid), dim3(NTHR), LDS_BYTES, stream, a);
#endif
}
```

```cpp
#include <hip/hip_runtime.h>
#include <cstdio>
#include <cstdint>

#ifndef MK_SPLIT
#define MK_SPLIT 0
#endif

#define GAS __attribute__((address_space(1)))
#define LAS __attribute__((address_space(3)))
typedef unsigned short bf16;
typedef short bf16x8 __attribute__((ext_vector_type(8)));
typedef float f32x4 __attribute__((ext_vector_type(4)));
typedef unsigned v4u __attribute__((ext_vector_type(4)));
typedef unsigned v2u __attribute__((ext_vector_type(2)));
#define RLX_AGENT __ATOMIC_RELAXED, __HIP_MEMORY_SCOPE_AGENT
#define LDS_WAIT() asm volatile("s_waitcnt lgkmcnt(0)" ::: "memory")

constexpr int NB = 4, SEQ = 4096, T = NB * SEQ, D = 1024;
constexpr int DC = 512, DS = 512, CW = 31, NG = 32, GH = 16, PS = 64;
constexpr int LC = 16, NCH = T / LC;
constexpr int MEML = 256, NXH = 4, XHD = 256;
constexpr int NE = 256, TOPK = 8, NEG = 8, TKG = 4, DE = 256;
constexpr int NASSIGN = T * TOPK;
constexpr float ALPHA = 1.189207115002721f;
constexpr float EPS = 1e-5f;
constexpr float ROUTED_SCALE = 2.5f;
constexpr int NWAVES = 8, NTHR = 512;

constexpr size_t MiB = 1u << 20;
constexpr size_t WS_CTL = 0, CTL_ZERO_BYTES = 1 * MiB;
constexpr size_t WS_W_IN_T = 1 * MiB;
constexpr size_t WS_W_GLU_T = 4 * MiB;
constexpr size_t WS_W_OUT_T = 5 * MiB;
constexpr size_t WS_WQ_T = 7 * MiB;
constexpr size_t WS_WKV_T = 9 * MiB;
constexpr size_t WS_WO_T = 13 * MiB;
constexpr size_t WS_WR_T = 15 * MiB;
constexpr size_t WS_SSM_W1 = 16 * MiB;
constexpr size_t WS_SSM_W2 = 18 * MiB;
constexpr size_t WS_SH_GU_T = 24 * MiB;
constexpr size_t WS_SH_D_T = 25 * MiB;
constexpr size_t WS_LAM16 = 25 * MiB + 512 * 1024;
constexpr size_t WS_MEMB = 26 * MiB;
constexpr size_t WS_KB = 28 * MiB;
constexpr size_t WS_VT = 30 * MiB;
constexpr size_t WS_WGU_T = 32 * MiB;
constexpr size_t WS_WD_T = 288 * MiB;
constexpr size_t WS_X2 = 416 * MiB;
constexpr size_t WS_X2B = 480 * MiB;
constexpr size_t WS_Y = 512 * MiB;
constexpr size_t WS_XB = 512 * MiB;
constexpr size_t WS_CV = 544 * MiB;
constexpr size_t WS_AS = 576 * MiB;
constexpr size_t WS_SEND = 600 * MiB;
constexpr size_t WS_Z = 616 * MiB;
constexpr size_t WS_ZG = 632 * MiB;
constexpr size_t WS_MERGED = 664 * MiB;
constexpr size_t WS_Y1 = 696 * MiB;
constexpr size_t WS_H = 768 * MiB;
constexpr size_t WS_Q = 768 * MiB;
constexpr size_t WS_O = 800 * MiB;
constexpr size_t WS_X1 = 832 * MiB;
constexpr size_t WS_X1B = 896 * MiB;
constexpr size_t WS_YS = 840 * MiB;
constexpr size_t WS_HS = 832 * MiB;
constexpr size_t WS_LOGITS = 872 * MiB;
constexpr size_t WS_TOPE = 928 * MiB;
constexpr size_t WS_TOPP = 928 * MiB + 512 * 1024;
constexpr size_t WS_GATE = 929 * MiB;
constexpr size_t WS_SLOT = 929 * MiB + 512 * 1024;
constexpr size_t WS_STOK = 930 * MiB;
constexpr size_t WS_SGATE = 931 * MiB;
constexpr size_t WS_END = 932 * MiB;
static_assert(WS_HS == WS_H + (size_t)NASSIGN * 256 * 2, "HS follows H");
constexpr int CW_BAR = 4096;
constexpr int CW_CNT = 16384;

constexpr int LDS_BYTES = 147456;
constexpr int MISC_OFF = 131072 + 320;

__device__ __forceinline__ unsigned f2bf(float f) { unsigned u = __builtin_bit_cast(unsigned, f); return (u + 0x7fffu + ((u >> 16) & 1u)) >> 16; }
__device__ __forceinline__ unsigned pk2(float lo, float hi) { return f2bf(lo) | (f2bf(hi) << 16); }
__device__ __forceinline__ float bf2f(unsigned h) { return __builtin_bit_cast(float, h << 16); }
__device__ __forceinline__ float bflo(unsigned w) { return __builtin_bit_cast(float, w << 16); }
__device__ __forceinline__ float bfhi(unsigned w) { return __builtin_bit_cast(float, w & 0xffff0000u); }
__device__ __forceinline__ float sigmoidf_(float x) { return __builtin_amdgcn_rcpf(1.0f + __expf(-x)); }
__device__ __forceinline__ float wave_sum(float v) {
#pragma unroll
    for (int o = 1; o < 64; o <<= 1) v += __shfl_xor(v, o);
    return v;
}
__device__ __forceinline__ float gelu_tanh(float x) {
    const float u = 0.7978845608028654f * (x + 0.044715f * x * x * x);
    const float t = 1.0f - 2.0f / (1.0f + __expf(2.0f * u));
    return 0.5f * x * (1.0f + t);
}

#define XB_TMO      128
#define XB_XCNT(j)  (256  + 64 * (j))
#define XB_XSUB(j)  (1280 + 64 * (j))
#define XB_XGEN(j)  (2304 + 64 * (j))
#define XB_TOP      3328
#define XB_TOPGEN   3392
#define XCD_BAR_WORDS 3456
#define XB_SPIN_CAP (1u << 20)

__device__ __forceinline__ unsigned xb_ld(unsigned* p)              { return __hip_atomic_load(p, __ATOMIC_RELAXED, __HIP_MEMORY_SCOPE_AGENT); }
__device__ __forceinline__ unsigned xb_add(unsigned* p, unsigned v) { return __hip_atomic_fetch_add(p, v, __ATOMIC_RELAXED, __HIP_MEMORY_SCOPE_AGENT); }
__device__ __forceinline__ unsigned xb_xcc_id() { return (unsigned)__builtin_amdgcn_s_getreg((3 << 11) | 20) & 0xFu; }
#define XB_SPIN(cond, bar) do { unsigned _sp = 0; while (cond) { __builtin_amdgcn_s_sleep(1); \
    if ((++_sp & 255u) == 0u) { if (xb_ld(&(bar)[XB_TMO])) break; if (_sp > XB_SPIN_CAP) { atomicAdd(&(bar)[XB_TMO], 1u); break; } } } } while (0)

struct XcdBarrier { unsigned* bar; unsigned x; volatile LAS unsigned* st; };

__device__ __forceinline__ XcdBarrier xcd_barrier_post(unsigned* bar, volatile LAS unsigned* st) {
    XcdBarrier b; b.bar = bar; b.x = xb_xcc_id(); b.st = st;
    if (threadIdx.x == 0) (void)xb_add(&bar[XB_XCNT(b.x)], 1u);
    return b;
}
__device__ __forceinline__ void xcd_barrier_complete(unsigned* bar, unsigned x, unsigned& nloc, unsigned& nx) {
    const unsigned G = gridDim.x * gridDim.y * gridDim.z;
    unsigned sum, cnt, mine, sp = 0u;
    for (;;) {
        sum = 0u; cnt = 0u; mine = 0u;
#pragma unroll
        for (unsigned j = 0; j < 16; ++j) { const unsigned c = xb_ld(&bar[XB_XCNT(j)]); sum += c; cnt += (c > 0u) ? 1u : 0u; mine = (j == x) ? c : mine; }
        if (sum == G) break;
        __builtin_amdgcn_s_sleep(1);
        if ((++sp & 255u) == 0u) { if (xb_ld(&bar[XB_TMO])) break; if (sp > XB_SPIN_CAP) { atomicAdd(&bar[XB_TMO], 1u); break; } }
    }
    nloc = mine > 0u ? mine : 1u; nx = cnt > 0u ? cnt : 1u;
}
__device__ __forceinline__ void xcd_barrier(const XcdBarrier& b) {
    asm volatile("s_waitcnt vmcnt(0)" ::: "memory");
    __syncthreads();
    if (threadIdx.x == 0) {
        unsigned* bar = b.bar;
        __builtin_amdgcn_s_waitcnt(0);
        unsigned nloc = b.st[0], nx = b.st[1];
        if (nloc == 0u) { xcd_barrier_complete(bar, b.x, nloc, nx); b.st[0] = nloc; b.st[1] = nx; }
        const unsigned old = xb_add(&bar[XB_XSUB(b.x)], 1u);
        const unsigned gen = old / nloc;
        if (old + 1u == (gen + 1u) * nloc) {
            __builtin_amdgcn_fence(__ATOMIC_RELEASE, "agent");
            asm volatile("s_waitcnt vmcnt(0)" ::: "memory");
            const unsigned og = xb_add(&bar[XB_TOP], 1u);
            const unsigned tg = og / nx;
            if (og + 1u == (tg + 1u) * nx) xb_add(&bar[XB_TOPGEN], 1u);
            else XB_SPIN(xb_ld(&bar[XB_TOPGEN]) == tg, bar);
            __builtin_amdgcn_fence(__ATOMIC_ACQUIRE, "agent");
            xb_add(&bar[XB_XGEN(b.x)], 1u);
            asm volatile("s_waitcnt vmcnt(0)" ::: "memory");
        } else {
            XB_SPIN(xb_ld(&bar[XB_XGEN(b.x)]) == gen, bar);
            __builtin_amdgcn_fence(__ATOMIC_ACQUIRE, "agent");
            asm volatile("s_waitcnt vmcnt(0)" ::: "memory");
        }
    }
    __syncthreads();
}

template <int MI, int NJ>
__device__ __forceinline__ void wave_mma(const bf16* (&ar)[MI], const bf16* (&br)[NJ], int K, f32x4 (&acc)[MI][NJ]) {
#pragma unroll 2
    for (int k = 0; k < K; k += 32) {
        bf16x8 a[MI], b[NJ];
#pragma unroll
        for (int i = 0; i < MI; ++i) a[i] = *(const bf16x8*)(ar[i] + k);
#pragma unroll
        for (int j = 0; j < NJ; ++j) b[j] = *(const bf16x8*)(br[j] + k);
#pragma unroll
        for (int i = 0; i < MI; ++i)
#pragma unroll
            for (int j = 0; j < NJ; ++j) acc[i][j] = __builtin_amdgcn_mfma_f32_16x16x32_bf16(b[j], a[i], acc[i][j], 0, 0, 0);
    }
}
template <int MI, int NJ>
__device__ __forceinline__ void zero_acc(f32x4 (&acc)[MI][NJ]) {
#pragma unroll
    for (int i = 0; i < MI; ++i)
#pragma unroll
        for (int j = 0; j < NJ; ++j) acc[i][j] = (f32x4){0.f, 0.f, 0.f, 0.f};
}


namespace pg8 {
constexpr int BM = 256, BK = 64, HALF = 128, HTB = HALF * BK * 2, STAGE_BYTES = 8 * HTB, NXCD = 8, WGM = 8;
__host__ __device__ __forceinline__ int lds_byte(int r, int c) { const int st = (r >> 4) * 2 + (c >> 5), rr = r & 15, cc = c & 31, ob = rr * 64 + cc * 2; return st * 1024 + (ob ^ (((ob >> 9) & 1) << 5)); }
__host__ __device__ __forceinline__ void stage_rc(int b, int& R, int& C) { const int st = b / 1024, sb = b % 1024, swz = sb ^ (((sb >> 9) & 1) << 5); R = (st >> 1) * 16 + swz / 64; C = (st & 1) * 32 + (swz % 64) / 2; }
__host__ __device__ __forceinline__ int perm32(int rho) { const int n = rho >> 4, i = rho & 15; return 8 * (i >> 2) + 4 * n + (i & 3); }
__device__ __forceinline__ unsigned cvt_pk_bf16(float lo, float hi) { unsigned r; asm volatile("v_cvt_pk_bf16_f32 %0, %1, %2" : "=v"(r) : "v"(lo), "v"(hi)); return r; }

struct Unit { int pm, pn, e, base, cnt; };

template <class Epi, class Sched, bool ALIGN_EPI>
__device__ __forceinline__ void gemm_phase(LAS unsigned char* lds, const int K, const Sched& S, const Epi& E) {
    const int tid = threadIdx.x, wid = __builtin_amdgcn_readfirstlane(tid >> 6), lane = tid & 63, wr = wid >> 2, wc = wid & 3, fr = lane & 15, fq = lane >> 4;
    const int nt = K / BK;
    unsigned voffB[2];
#pragma unroll
    for (int i = 0; i < 2; ++i) { int R, C; stage_rc(tid * 16 + i * 8192, R, C); const int Rb = Epi::PERM ? ((R & ~31) + perm32(R & 31)) : R; voffB[i] = (unsigned)(Rb * K + C) * 2u; }
    const size_t kstep = (size_t)(BK * 2);
    const size_t hB = S.b_hstep(K);
    const unsigned ldsw = (unsigned)wid * 1024u;
    const int aoff = lds_byte(wr * 64 + fr, fq * 8), boff = lds_byte(wc * 32 + fr, fq * 8);
#define PG8_SA(b, h) (((b) * 2 + (h)) * HTB)
#define PG8_SB(b, h) ((4 + (b) * 2 + (h)) * HTB)
#define PG8_STAGE(bufoff, gbase, voff) do { _Pragma("unroll") for (int _i = 0; _i < 2; ++_i) \
        __builtin_amdgcn_global_load_lds((const unsigned*)((const char*)(gbase) + (voff)[_i]), (LAS unsigned*)(lds + (bufoff) + ldsw + _i * 8192), 16, 0, 0); } while (0)
#define PG8_LDA(dst, b, h) do { _Pragma("unroll") for (int m = 0; m < 4; ++m) _Pragma("unroll") for (int k = 0; k < 2; ++k) dst[m][k] = *(const LAS bf16x8*)(lds + PG8_SA(b, h) + aoff + m * 2048 + k * 1024); } while (0)
#define PG8_LDB(dst, b, h) do { _Pragma("unroll") for (int n = 0; n < 2; ++n) _Pragma("unroll") for (int k = 0; k < 2; ++k) dst[n][k] = *(const LAS bf16x8*)(lds + PG8_SB(b, h) + boff + n * 2048 + k * 1024); } while (0)
#define PG8_MMA(ai, bj, At, Bt) do { __builtin_amdgcn_s_setprio(1); _Pragma("unroll") for (int m = 0; m < 4; ++m) _Pragma("unroll") for (int n = 0; n < 2; ++n) _Pragma("unroll") for (int k = 0; k < 2; ++k) \
        acc[ai][bj][m][n] = __builtin_amdgcn_mfma_f32_16x16x32_bf16(Bt[n][k], At[m][k], acc[ai][bj][m][n], 0, 0, 0); __builtin_amdgcn_s_setprio(0); } while (0)
#define PG8_WAIT_V(n) asm volatile("s_waitcnt vmcnt(" #n ")" ::: "memory")
#define PG8_WAIT_L(n) asm volatile("s_waitcnt lgkmcnt(" #n ")" ::: "memory")
#define PG8_BAR __builtin_amdgcn_s_barrier()
#define PG8_SCHED __builtin_amdgcn_sched_barrier(0)
    Unit cur, nxt; int ui = 0;
    if (!S.next(0, cur)) return;
    f32x4 acc[2][2][4][2];
#pragma unroll
    for (int a = 0; a < 2; ++a)
#pragma unroll
        for (int b = 0; b < 2; ++b)
#pragma unroll
            for (int m = 0; m < 4; ++m)
#pragma unroll
                for (int n = 0; n < 2; ++n) acc[a][b][m][n] = (f32x4){0.f, 0.f, 0.f, 0.f};
    bf16x8 At[4][2], B0[2][2], B1[2][2];
    unsigned va[4], vn[4];
    S.a_off(cur, tid, K, va);
    const char* cA = S.a_base(cur); const char* cB = S.b_base(cur);
    PG8_STAGE(PG8_SB(0, 0), cB, voffB); PG8_STAGE(PG8_SB(0, 1), cB + hB, voffB); PG8_STAGE(PG8_SA(0, 0), cA, va); PG8_STAGE(PG8_SA(0, 1), cA, va + 2);
    if (wr == 1) PG8_BAR;
    PG8_WAIT_V(2); PG8_BAR;
    PG8_STAGE(PG8_SB(1, 0), cB + kstep, voffB); PG8_STAGE(PG8_SA(1, 0), cA + kstep, va); PG8_STAGE(PG8_SB(1, 1), cB + hB + kstep, voffB);
    PG8_WAIT_V(6); PG8_BAR;
    for (;;) {
        const bool has_next = S.next(ui + 1, nxt);
        const char* nA = has_next ? S.a_base(nxt) : cA; const char* nB = has_next ? S.b_base(nxt) : cB;
        if constexpr (Sched::EARLY_OFF) { if (has_next) S.a_pre(nxt, tid, vn); }
#pragma nounroll
        for (int t = 0; t < nt; t += 2) {
            const bool last = (t == nt - 2);
            const char* a1 = cA + (size_t)(t + 1) * kstep;
            const char* a2 = last ? nA : cA + (size_t)(t + 2) * kstep; const char* b2 = last ? nB : cB + (size_t)(t + 2) * kstep;
            const char* a3 = a2 + kstep; const char* b3 = b2 + kstep;
            PG8_LDB(B0, 0, 0); PG8_LDB(B1, 0, 1); PG8_SCHED; PG8_LDA(At, 0, 0); PG8_STAGE(PG8_SA(1, 1), a1, va + 2);
            PG8_WAIT_V(8); PG8_WAIT_L(0); PG8_BAR; PG8_MMA(0, 0, At, B0); PG8_MMA(0, 1, At, B1); PG8_BAR; PG8_SCHED;
            if (last) {
                if (has_next) { if constexpr (Sched::EARLY_OFF) S.a_fin(nxt, tid, K, vn, va); else S.a_off(nxt, tid, K, va); } }
            PG8_LDA(At, 0, 1); PG8_STAGE(PG8_SB(0, 0), b2, voffB); PG8_STAGE(PG8_SB(0, 1), b2 + hB, voffB); PG8_STAGE(PG8_SA(0, 0), a2, va);
            PG8_WAIT_V(8); PG8_WAIT_L(0); PG8_BAR; PG8_MMA(1, 0, At, B0); PG8_MMA(1, 1, At, B1); PG8_BAR; PG8_SCHED;
            PG8_LDB(B0, 1, 0); PG8_LDB(B1, 1, 1); PG8_SCHED; PG8_LDA(At, 1, 0); PG8_STAGE(PG8_SA(0, 1), a2, va + 2);
            PG8_WAIT_V(8); PG8_WAIT_L(0); PG8_BAR; PG8_MMA(0, 0, At, B0); PG8_MMA(0, 1, At, B1); PG8_BAR; PG8_SCHED;
            PG8_LDA(At, 1, 1); PG8_STAGE(PG8_SB(1, 0), b3, voffB); PG8_STAGE(PG8_SB(1, 1), b3 + hB, voffB); PG8_STAGE(PG8_SA(1, 0), a3, va);
            PG8_WAIT_V(8); PG8_WAIT_L(0); PG8_BAR; PG8_MMA(1, 0, At, B0); PG8_MMA(1, 1, At, B1); PG8_BAR; PG8_SCHED;
        }
        if constexpr (ALIGN_EPI) { if (wr == 0) PG8_BAR; }
        E(acc, cur, wr, wc, fr, fq);
        if (!has_next) break;
#pragma unroll
        for (int a = 0; a < 2; ++a)
#pragma unroll
            for (int b = 0; b < 2; ++b)
#pragma unroll
                for (int m = 0; m < 4; ++m)
#pragma unroll
                    for (int n = 0; n < 2; ++n) acc[a][b][m][n] = (f32x4){0.f, 0.f, 0.f, 0.f};
        cur = nxt; cA = nA; cB = nB; ++ui;
        if constexpr (ALIGN_EPI) { if (wr == 1) PG8_BAR; }
    }
    PG8_WAIT_V(0);
    if constexpr (!ALIGN_EPI) { if (wr == 0) PG8_BAR; }
    PG8_BAR;
#undef PG8_SA
#undef PG8_SB
#undef PG8_STAGE
#undef PG8_LDA
#undef PG8_LDB
#undef PG8_MMA
#undef PG8_WAIT_V
#undef PG8_WAIT_L
#undef PG8_BAR
#undef PG8_SCHED
}

__device__ __forceinline__ int xcd_deal(int i, int G, int c, int total) {
    const int per = (total + 7) >> 3, x = c & 7, j = i * (G >> 3) + (c >> 3);
    if (j >= per) return -1; const int u = x * per + j; return u < total ? u : -1;
}

struct DenseSched {
    static constexpr bool EARLY_OFF = false;
    const char* A; const char* Bt; int nM, nN, nwg, G, c, K;
    __device__ __forceinline__ void init(const void* A_, const void* Bt_, int M, int N, int K_, int G_, int c_) { A = (const char*)A_; Bt = (const char*)Bt_; nM = M / BM; nN = N / BM; nwg = nM * nN; G = G_; c = c_; K = K_; }
    __device__ __forceinline__ bool next(int i, Unit& u) const {
        const long L = (long)i * G + c; if (L >= nwg) return false;
        int wgid = (int)L; { const int q = nwg / NXCD, r = nwg % NXCD, xcd = wgid % NXCD, off = wgid / NXCD; wgid = (xcd < r ? xcd * (q + 1) : r * (q + 1) + (xcd - r) * q) + off; }
        const int nig = WGM * nN, gid = wgid / nig, fm = gid * WGM, gsz = (nM - fm) < WGM ? (nM - fm) : WGM;
        u.pm = fm + ((wgid % nig) % gsz); u.pn = (wgid % nig) / gsz; u.e = 0; u.base = u.pm * BM; u.cnt = BM; return true;
    }
    __device__ __forceinline__ const char* a_base(const Unit&) const { return A; }
    __device__ __forceinline__ void a_off(const Unit& u, int tid, int K_, unsigned (&vo)[4]) const {
        asm volatile("" : "+v"(tid)); int Ra[2], Ca[2]; stage_rc(tid * 16, Ra[0], Ca[0]); stage_rc(tid * 16 + 8192, Ra[1], Ca[1]);
#pragma unroll
        for (int h = 0; h < 2; ++h)
#pragma unroll
            for (int i = 0; i < 2; ++i) vo[h * 2 + i] = (unsigned)((u.pm * BM + h * HALF + Ra[i]) * K_ + Ca[i]) * 2u;
    }
    __device__ __forceinline__ const char* b_base(const Unit& u) const { return Bt + (size_t)u.pn * BM * K * 2; }
    __device__ __forceinline__ size_t b_hstep(int K_) const { return (size_t)HALF * K_ * 2; }
};
}

struct ProjSched {
    static constexpr bool EARLY_OFF = false;
    const char *XBp, *WINp, *MEMBp, *WKVp; int G, c;
    __device__ __forceinline__ bool next(int i, pg8::Unit& u) const {
        const int L = i * G + c; if (L >= 416) return false;
        int pm, pn, e;
        if (L < 384) { const int wgid = (L & 7) * 48 + (L >> 3);
            pm = (wgid / 48) * 8 + (wgid % 48) % 8; pn = (wgid % 48) / 8; e = 0; }
        else { const int q = L - 384; pm = q >> 3; pn = q & 7; e = 1; }
        u.pm = pm; u.pn = pn; u.e = e; u.base = pm * 256; u.cnt = 256;
        return true;
    }
    __device__ __forceinline__ const char* a_base(const pg8::Unit& u) const { return u.e ? MEMBp : XBp; }
    __device__ __forceinline__ void a_off(const pg8::Unit& u, int tid, int K_, unsigned (&vo)[4]) const {
        asm volatile("" : "+v"(tid)); int Ra[2], Ca[2]; pg8::stage_rc(tid * 16, Ra[0], Ca[0]); pg8::stage_rc(tid * 16 + 8192, Ra[1], Ca[1]);
#pragma unroll
        for (int h = 0; h < 2; ++h)
#pragma unroll
            for (int i = 0; i < 2; ++i) vo[h * 2 + i] = (unsigned)((u.pm * 256 + h * 128 + Ra[i]) * K_ + Ca[i]) * 2u;
    }
    __device__ __forceinline__ const char* b_base(const pg8::Unit& u) const { return (u.e ? WKVp : WINp) + (size_t)u.pn * 256 * 1024 * 2; }
    __device__ __forceinline__ size_t b_hstep(int K_) const { return (size_t)128 * K_ * 2; }
};
struct EpiProj {
    static constexpr bool PERM = true;
    bf16 *CV, *AS, *KB, *VT;
    __device__ __forceinline__ void operator()(const f32x4 (&acc)[2][2][4][2], const pg8::Unit& u, int wr, int wc, int fr, int fq) const {
        int r0 = wr * 64 + fr; asm volatile("" : "+v"(r0));
#pragma unroll
        for (int ai = 0; ai < 2; ++ai)
#pragma unroll
            for (int m = 0; m < 4; ++m) { const int row = u.pm * 256 + ai * 128 + m * 16 + r0;
#pragma unroll
                for (int bj = 0; bj < 2; ++bj) { const int col = u.pn * 256 + bj * 128 + wc * 32 + 8 * fq; const f32x4 v0 = acc[ai][bj][m][0], v1 = acc[ai][bj][m][1];
                    v4u w; w.x = pg8::cvt_pk_bf16(v0[0], v0[1]); w.y = pg8::cvt_pk_bf16(v0[2], v0[3]); w.z = pg8::cvt_pk_bf16(v1[0], v1[1]); w.w = pg8::cvt_pk_bf16(v1[2], v1[3]);
                    if (u.e == 0) { if (u.pn < 4) *(v4u*)(CV + (size_t)row * 1024 + col) = w;
                        else { const int ch = col - 1024, g = ch >> 4, h = ch & 15; *(v4u*)(AS + ((size_t)(g * NCH + (row >> 4)) * 384 + (row & 15) * 16 + h)) = w; } }
                    else { if (u.pn < 4) *(v4u*)(KB + (size_t)row * 1024 + col) = w;
                        else { const int d = col - 1024, b = row >> 8, key = row & 255; bf16* vp = VT + ((size_t)(b * 1024 + d)) * 256 + key;
                            vp[0 * 256] = (bf16)(w.x & 0xffffu); vp[1 * 256] = (bf16)(w.x >> 16); vp[2 * 256] = (bf16)(w.y & 0xffffu); vp[3 * 256] = (bf16)(w.y >> 16);
                            vp[4 * 256] = (bf16)(w.z & 0xffffu); vp[5 * 256] = (bf16)(w.z >> 16); vp[6 * 256] = (bf16)(w.w & 0xffffu); vp[7 * 256] = (bf16)(w.w >> 16); } } } }
    }
};
struct EpiResF32 {
    static constexpr bool PERM = false;
    const float* res; float* out;
    __device__ __forceinline__ void operator()(const f32x4 (&acc)[2][2][4][2], const pg8::Unit& u, int wr, int wc, int fr, int fq) const {
        int r0 = wr * 64 + fr; asm volatile("" : "+v"(r0));
#pragma unroll
        for (int ai = 0; ai < 2; ++ai)
#pragma unroll
            for (int m = 0; m < 4; ++m) { const size_t ro = (size_t)(u.pm * 256 + ai * 128 + m * 16 + r0) * D + u.pn * 256 + wc * 32 + 4 * fq;
#pragma unroll
                for (int bj = 0; bj < 2; ++bj)
#pragma unroll
                    for (int n = 0; n < 2; ++n) { const size_t o = ro + bj * 128 + n * 16; const f32x4 r = *(const f32x4*)(res + o); *(f32x4*)(out + o) = r * ALPHA + acc[ai][bj][m][n]; } }
    }
};
struct EpiBf16S {
    static constexpr bool PERM = true;
    bf16* out; float scale;
    __device__ __forceinline__ void operator()(const f32x4 (&acc)[2][2][4][2], const pg8::Unit& u, int wr, int wc, int fr, int fq) const {
        int r0 = wr * 64 + fr; asm volatile("" : "+v"(r0));
#pragma unroll
        for (int ai = 0; ai < 2; ++ai)
#pragma unroll
            for (int m = 0; m < 4; ++m) { const size_t ro = (size_t)(u.pm * 256 + ai * 128 + m * 16 + r0) * D + u.pn * 256 + wc * 32 + 8 * fq;
#pragma unroll
                for (int bj = 0; bj < 2; ++bj) { const f32x4 v0 = acc[ai][bj][m][0] * scale, v1 = acc[ai][bj][m][1] * scale;
                    v4u w; w.x = pg8::cvt_pk_bf16(v0[0], v0[1]); w.y = pg8::cvt_pk_bf16(v0[2], v0[3]); w.z = pg8::cvt_pk_bf16(v1[0], v1[1]); w.w = pg8::cvt_pk_bf16(v1[2], v1[3]);
                    *(v4u*)(out + ro + bj * 128) = w; } }
    }
};
template <bool GATEUP>
struct MoeSched {
    static constexpr int NPN = GATEUP ? 2 : 4; static constexpr bool EARLY_OFF = GATEUP;
    const bf16 *X, *XS, *W, *WS; const int* stok; const LAS int* off; const LAS int* tst; int nmoe, total, G, c; LAS unsigned char* tokl;
    __device__ __forceinline__ bool next(int i, pg8::Unit& u) const {
        const int idx = pg8::xcd_deal(i, G, c, total); if (idx < 0) return false;
        const int mtg = idx / NPN; u.pn = idx % NPN;
        if (mtg >= nmoe) { u.e = 256; u.pm = mtg - nmoe; u.base = (GATEUP ? NASSIGN : 0) + u.pm * 256; u.cnt = 256; }
        else { int lo_ = 0, hi_ = 256; while (hi_ - lo_ > 1) { const int mid = (lo_ + hi_) >> 1; if (tst[mid] <= mtg) lo_ = mid; else hi_ = mid; }
            u.e = lo_; u.pm = mtg - tst[lo_]; u.base = off[lo_] + u.pm * 256; u.cnt = off[lo_ + 1] - u.base; }
        u.e = __builtin_amdgcn_readfirstlane(u.e); u.pm = __builtin_amdgcn_readfirstlane(u.pm); u.pn = __builtin_amdgcn_readfirstlane(u.pn);
        u.base = __builtin_amdgcn_readfirstlane(u.base); u.cnt = __builtin_amdgcn_readfirstlane(u.cnt);
        return true;
    }
    __device__ __forceinline__ const char* a_base(const pg8::Unit& u) const { return (const char*)((!GATEUP && u.e == 256) ? XS : X); }
    __device__ __forceinline__ void a_pre(const pg8::Unit& u, int tid, unsigned (&vr)[4]) const {
        asm volatile("" : "+v"(tid)); int Ra[2], Ca[2]; pg8::stage_rc(tid * 16, Ra[0], Ca[0]); pg8::stage_rc(tid * 16 + 8192, Ra[1], Ca[1]);
        if constexpr (GATEUP) { const int* sp = stok + u.base; const int cm = u.cnt - 1;
            const int wv = __builtin_amdgcn_readfirstlane(tid >> 6);
#pragma unroll
            for (int h = 0; h < 2; ++h)
#pragma unroll
                for (int i = 0; i < 2; ++i) { const int r = h * 128 + Ra[i];
                    __builtin_amdgcn_global_load_lds((const unsigned*)(sp + (r < cm ? r : cm)), (LAS unsigned*)(tokl + wv * 1024 + (h * 2 + i) * 256), 4, 0, 0); vr[h * 2 + i] = 0u; } }
        else {
#pragma unroll
            for (int h = 0; h < 2; ++h)
#pragma unroll
                for (int i = 0; i < 2; ++i) vr[h * 2 + i] = (unsigned)(u.base + h * 128 + Ra[i]); }
    }
    __device__ __forceinline__ void a_fin(const pg8::Unit& u, int tid, int K_, const unsigned (&vr)[4], unsigned (&vo)[4]) const {
        asm volatile("" : "+v"(tid)); int Ra[2], Ca[2]; pg8::stage_rc(tid * 16, Ra[0], Ca[0]); pg8::stage_rc(tid * 16 + 8192, Ra[1], Ca[1]);
#pragma unroll
        for (int h = 0; h < 2; ++h)
#pragma unroll
            for (int i = 0; i < 2; ++i) { unsigned rv;
                if constexpr (GATEUP) rv = *(const LAS unsigned*)(tokl + (tid >> 6) * 1024 + (h * 2 + i) * 256 + (tid & 63) * 4); else rv = vr[h * 2 + i];
                vo[h * 2 + i] = (rv * (unsigned)K_ + (unsigned)Ca[i]) * 2u; }
    }
    __device__ __forceinline__ void a_off(const pg8::Unit& u, int tid, int K_, unsigned (&vo)[4]) const { unsigned vr[4]; a_pre(u, tid, vr); if constexpr (GATEUP) asm volatile("s_waitcnt vmcnt(0)" ::: "memory"); a_fin(u, tid, K_, vr, vo); }
    __device__ __forceinline__ const char* b_base(const pg8::Unit& u) const {
        if (GATEUP) return (const char*)((u.e == 256 ? WS : W + (size_t)u.e * 512 * 1024) + (size_t)u.pn * 128 * 1024);
        else return (const char*)((u.e == 256 ? WS : W + (size_t)u.e * 1024 * 256) + (size_t)u.pn * 256 * 256);
    }
    __device__ __forceinline__ size_t b_hstep(int K_) const { return GATEUP ? (size_t)256 * K_ * 2 : (size_t)128 * K_ * 2; }
};
struct EpiGateUp {
    static constexpr bool PERM = true;
    bf16 *H, *HS;
    __device__ __forceinline__ void operator()(const f32x4 (&acc)[2][2][4][2], const pg8::Unit& u, int wr, int wc, int fr, int fq) const {
        int r0 = wr * 64 + fr; asm volatile("" : "+v"(r0));
        bf16* bp = H + (size_t)u.base * DE + u.pn * 128 + wc * 32 + 8 * fq;
#pragma unroll
        for (int ai = 0; ai < 2; ++ai)
#pragma unroll
            for (int m = 0; m < 4; ++m) { const int r = ai * 128 + m * 16 + r0;
                if (r < u.cnt) { float hv[8];
#pragma unroll
                    for (int n = 0; n < 2; ++n)
#pragma unroll
                        for (int j = 0; j < 4; ++j) { const float g = acc[ai][0][m][n][j], up = acc[ai][1][m][n][j]; hv[n * 4 + j] = g * sigmoidf_(g) * up; }
                    v4u w; w.x = pg8::cvt_pk_bf16(hv[0], hv[1]); w.y = pg8::cvt_pk_bf16(hv[2], hv[3]); w.z = pg8::cvt_pk_bf16(hv[4], hv[5]); w.w = pg8::cvt_pk_bf16(hv[6], hv[7]);
                    *(v4u*)(bp + (size_t)r * DE) = w; } }
    }
};
struct EpiDown {
    static constexpr bool PERM = true;
    bf16 *Y, *YS; const float* sgate;
    __device__ __forceinline__ void operator()(const f32x4 (&acc)[2][2][4][2], const pg8::Unit& u, int wr, int wc, int fr, int fq) const {
        int r0 = wr * 64 + fr; asm volatile("" : "+v"(r0));
        bf16* bp = (u.e == 256 ? YS : Y) + (size_t)u.base * D + u.pn * 256 + wc * 32 + 8 * fq;
#pragma unroll
        for (int ai = 0; ai < 2; ++ai)
#pragma unroll
            for (int m = 0; m < 4; ++m) { const int r = ai * 128 + m * 16 + r0;
                if (r < u.cnt) { const float gt = (u.e == 256) ? 1.0f : sgate[u.base + r];
#pragma unroll
                    for (int bj = 0; bj < 2; ++bj) { const f32x4 v0 = acc[ai][bj][m][0] * gt, v1 = acc[ai][bj][m][1] * gt;
                        v4u w; w.x = pg8::cvt_pk_bf16(v0[0], v0[1]); w.y = pg8::cvt_pk_bf16(v0[2], v0[3]); w.z = pg8::cvt_pk_bf16(v1[0], v1[1]); w.w = pg8::cvt_pk_bf16(v1[2], v1[3]);
                        *(v4u*)(bp + (size_t)r * D + bj * 128) = w; } } }
    }
};

__device__ __forceinline__ void p0_transpose_item(const float* W, int K, int N, bf16* WT, int row_off, LAS float* scr, int item, int lane) {
    const int nblk = N / 32, kb = item / nblk, nb = item % nblk, k0 = 64 * kb, n0 = 32 * nb;
#pragma unroll 8
    for (int i = 0; i < 32; ++i) { const int kk = 2 * i + (lane >> 5); scr[kk * 33 + (lane & 31)] = W[(size_t)(k0 + kk) * N + n0 + (lane & 31)]; }
    LDS_WAIT(); asm volatile("" ::: "memory");
    const int c = lane & 7;
#pragma unroll
    for (int j = 0; j < 4; ++j) { const int n = (lane >> 3) + 8 * j; const LAS float* s = scr + (8 * c) * 33 + n;
        v4u o; o.x = pk2(s[0 * 33], s[1 * 33]); o.y = pk2(s[2 * 33], s[3 * 33]); o.z = pk2(s[4 * 33], s[5 * 33]); o.w = pk2(s[6 * 33], s[7 * 33]);
        *(v4u*)(WT + (size_t)(row_off + n0 + n) * K + k0 + 8 * c) = o; }
    LDS_WAIT(); asm volatile("" ::: "memory");
}

__device__ __forceinline__ void sincos_d(double x, float& s, float& c) {
    const double k = __builtin_rint(x * 0.63661977236758134308);
    double r = __builtin_fma(-k, 1.57079632679489655800e+00, x); r = __builtin_fma(-k, 6.12323399573676603587e-17, r);
    const int q = ((int)k) & 3;
    const float rf = (float)r, z = rf * rf;
    const float sp = rf + rf * z * (-1.6666667163e-01f + z * (8.3333337680e-03f + z * (-1.9841270114e-04f + z * 2.7557314297e-06f)));
    const float cp = 1.0f - 0.5f * z + z * z * (4.1666667908e-02f + z * (-1.3888889225e-03f + z * (2.4801587642e-05f + z * -2.7557314297e-07f)));
    s = (q == 0) ? sp : (q == 1) ? cp : (q == 2) ? -sp : -cp;
    c = (q == 0) ? cp : (q == 1) ? -sp : (q == 2) ? -cp : sp;
}

__device__ __forceinline__ void p0_ssm_group(int g, int tid, LAS unsigned char* lds, const float* log_dt, const float* a_re, const float* a_im,
                                             const float* b_re, const float* b_im, const float* c_re, const float* c_im, bf16* W1, bf16* W2, float* LAM16) {
    LAS float* lp_re = (LAS float*)lds;
    LAS float* lp_im = lp_re + 17 * 64;
    LAS float* bb_re = lp_im + 17 * 64;
    LAS float* bb_im = bb_re + 1024;
    LAS float* cc_re = bb_im + 1024;
    LAS float* cc_im = cc_re + 1024;
    LAS float* ktab = cc_im + 1024;
    __syncthreads();
    const float dt = __expf(log_dt[g]);
    if (tid < 64) {
        const int p = tid; const float a = a_re[g * 64 + p], w = a_im[g * 64 + p];
        for (int tau = 0; tau <= 16; ++tau) { float s, c; sincos_d((double)w * (double)dt * (double)tau, s, c); const float mg = __expf(a * dt * (float)tau);
            lp_re[tau * 64 + p] = mg * c; lp_im[tau * 64 + p] = mg * s; }
        const float lr = lp_re[64 + p], li = lp_im[64 + p];
        const float den = a * a + w * w;
        const float cr = ((lr - 1.0f) * a + li * w) / den, ci = (li * a - (lr - 1.0f) * w) / den;
        for (int h = 0; h < 16; ++h) { const float br = b_re[(g * 64 + p) * 16 + h], bi = b_im[(g * 64 + p) * 16 + h];
            bb_re[p * 16 + h] = cr * br - ci * bi; bb_im[p * 16 + h] = cr * bi + ci * br; }
        LAM16[(g * 64 + p) * 2 + 0] = lp_re[16 * 64 + p]; LAM16[(g * 64 + p) * 2 + 1] = lp_im[16 * 64 + p];
    }
    for (int i = tid; i < 1024; i += NTHR) { cc_re[i] = c_re[g * 1024 + i]; cc_im[i] = c_im[g * 1024 + i]; }
    __syncthreads();
    for (int e = tid; e < 4096; e += NTHR) { const int tau = e >> 8, h = (e >> 4) & 15, hp = e & 15; float acc = 0.f;
        for (int p = 0; p < 64; ++p) { const float lr = lp_re[tau * 64 + p], li = lp_im[tau * 64 + p], br = bb_re[p * 16 + hp], bi = bb_im[p * 16 + hp];
            const float zr = lr * br - li * bi, zi = lr * bi + li * br;
            acc += cc_re[h * 64 + p] * zr - cc_im[h * 64 + p] * zi; }
        ktab[e] = acc; }
    __syncthreads();
    bf16* w1 = W1 + (size_t)g * 128 * 256;
    for (int e = tid; e < 128 * 256; e += NTHR) { const int n = e >> 8, k = e & 255, p = n & 63, j = k >> 4, hp = k & 15, tau = 15 - j;
        const float lr = lp_re[tau * 64 + p], li = lp_im[tau * 64 + p], br = bb_re[p * 16 + hp], bi = bb_im[p * 16 + hp];
        const float v = (n < 64) ? (lr * br - li * bi) : (lr * bi + li * br);
        w1[e] = (bf16)f2bf(v); }
    bf16* w2 = W2 + (size_t)g * 256 * 384;
    for (int e = tid; e < 256 * 384; e += NTHR) { const int n = e / 384, k = e % 384, i = n >> 4, h = n & 15; float v;
        if (k < 256) { const int j = k >> 4, hp = k & 15; v = (j <= i) ? ktab[((i - j) << 8) + (h << 4) + hp] : 0.f; }
        else { const int q = k - 256, p = q & 63, tau = i + 1; const float lr = lp_re[tau * 64 + p], li = lp_im[tau * 64 + p], cr = cc_re[h * 64 + p], ci = cc_im[h * 64 + p];
            v = (q < 64) ? (cr * lr - ci * li) : -(cr * li + ci * lr); }
        w2[e] = (bf16)f2bf(v); }
    __syncthreads();
}

struct Args { const float* in[38]; float* out; unsigned char* ws; int ph_lo, ph_hi; };

constexpr int N_PHASES = 19;

__global__ void __launch_bounds__(NTHR, 2) fwd(Args args) {
    extern __shared__ __attribute__((aligned(16))) unsigned char lds_raw[];
    LAS unsigned char* lds = (LAS unsigned char*)lds_raw;
    volatile LAS unsigned* MISC = (volatile LAS unsigned*)(lds + MISC_OFF);
    const int tid = threadIdx.x, lane = tid & 63, wave = __builtin_amdgcn_readfirstlane(tid >> 6);
    const int G = gridDim.x; const int bx = blockIdx.x; const int vcu = (G % 8 == 0) ? (bx % 8) * (G / 8) + bx / 8 : bx;
    const int gw = vcu * NWAVES + wave, ngw = G * NWAVES;
    const int gtid = vcu * NTHR + tid, ngt = G * NTHR;
    const int fr = lane & 15, fq = lane >> 4;
    unsigned char* ws = args.ws;
    unsigned* ctl = (unsigned*)(ws + WS_CTL);
    for (int u = tid; u < (LDS_BYTES - 131072) / 4; u += NTHR) ((LAS unsigned*)(lds + 131072))[u] = 0u;
    __syncthreads();
#if MK_SPLIT
#define GRID_BAR() do { } while (0)
#else
    XcdBarrier bar = xcd_barrier_post(ctl + CW_BAR, MISC + 8);
#define GRID_BAR() xcd_barrier(bar)
#endif
    const int lo = args.ph_lo, hi = args.ph_hi;
#ifndef ONLY_PHASE
#define ONLY_PHASE -1
#endif
#define IN(k) ((ONLY_PHASE < 0 || ONLY_PHASE == (k)) && lo <= (k) && (k) < hi)
#define BOTH(k) (IN(k) && IN((k) + 1))

    const float* x = args.in[0];
    bf16* XB = (bf16*)(ws + WS_XB); bf16* CV = (bf16*)(ws + WS_CV); bf16* AS = (bf16*)(ws + WS_AS); float* SEND = (float*)(ws + WS_SEND);
    bf16* Z = (bf16*)(ws + WS_Z); float* ZG = (float*)(ws + WS_ZG); bf16* MERGED = (bf16*)(ws + WS_MERGED); float* Y1 = (float*)(ws + WS_Y1);
    float* X1 = (float*)(ws + WS_X1); bf16* X1B = (bf16*)(ws + WS_X1B); bf16* Q = (bf16*)(ws + WS_Q); bf16* O = (bf16*)(ws + WS_O);
    float* X2 = (float*)(ws + WS_X2); bf16* X2B = (bf16*)(ws + WS_X2B); float* LOGITS = (float*)(ws + WS_LOGITS);
    bf16* H = (bf16*)(ws + WS_H); bf16* HS = (bf16*)(ws + WS_HS); bf16* Y = (bf16*)(ws + WS_Y); bf16* YS = (bf16*)(ws + WS_YS);
    bf16* W_IN_T = (bf16*)(ws + WS_W_IN_T); bf16* W_GLU_T = (bf16*)(ws + WS_W_GLU_T); bf16* W_OUT_T = (bf16*)(ws + WS_W_OUT_T);
    bf16* WQ_T = (bf16*)(ws + WS_WQ_T); bf16* WKV_T = (bf16*)(ws + WS_WKV_T); bf16* WO_T = (bf16*)(ws + WS_WO_T); bf16* WR_T = (bf16*)(ws + WS_WR_T);
    bf16* SSM_W1 = (bf16*)(ws + WS_SSM_W1); bf16* SSM_W2 = (bf16*)(ws + WS_SSM_W2); float* LAM16 = (float*)(ws + WS_LAM16);
    bf16* SH_GU_T = (bf16*)(ws + WS_SH_GU_T); bf16* SH_D_T = (bf16*)(ws + WS_SH_D_T);
    bf16* MEMB = (bf16*)(ws + WS_MEMB); bf16* KB = (bf16*)(ws + WS_KB); bf16* VT = (bf16*)(ws + WS_VT);
    bf16* WGU_T = (bf16*)(ws + WS_WGU_T); bf16* WD_T = (bf16*)(ws + WS_WD_T);
    int* TOPE = (int*)(ws + WS_TOPE); int* TOPP = (int*)(ws + WS_TOPP); float* GATE = (float*)(ws + WS_GATE); int* SLOT = (int*)(ws + WS_SLOT);
    int* STOK = (int*)(ws + WS_STOK); float* SGATE = (float*)(ws + WS_SGATE);
    unsigned* CNT = ctl + CW_CNT;

    if (IN(0)) {
        LAS float* scr = (LAS float*)(lds + wave * 16384);
        constexpr int I_SMALL = 768 + 128 + 512 * 4 + 512 + 128 * 4;
        constexpr int NITEMS = I_SMALL + NE * 384;
        for (int it = gw; it < NITEMS; it += ngw) {
            int r = it;
            if (r >= I_SMALL) { r -= I_SMALL; const int e = r / 384, q = r % 384;
                if (q < 128) p0_transpose_item(args.in[30] + (size_t)e * D * DE, D, DE, WGU_T + (size_t)e * 512 * D, 0, scr, q, lane);
                else if (q < 256) p0_transpose_item(args.in[31] + (size_t)e * D * DE, D, DE, WGU_T + (size_t)e * 512 * D, 256, scr, q - 128, lane);
                else p0_transpose_item(args.in[32] + (size_t)e * DE * D, DE, D, WD_T + (size_t)e * D * DE, 0, scr, q - 256, lane);
                continue; }
            if (r < 768) { p0_transpose_item(args.in[2], D, 1536, W_IN_T, 0, scr, r, lane); continue; } r -= 768;
            if (r < 128) { p0_transpose_item(args.in[15], 512, 512, W_GLU_T, 0, scr, r, lane); continue; } r -= 128;
            if (r < 512) { p0_transpose_item(args.in[19], D, D, W_OUT_T, 0, scr, r, lane); continue; } r -= 512;
            if (r < 512) { p0_transpose_item(args.in[22], D, D, WQ_T, 0, scr, r, lane); continue; } r -= 512;
            if (r < 512) { p0_transpose_item(args.in[23], D, D, WKV_T, 0, scr, r, lane); continue; } r -= 512;
            if (r < 512) { p0_transpose_item(args.in[24], D, D, WKV_T, 1024, scr, r, lane); continue; } r -= 512;
            if (r < 512) { p0_transpose_item(args.in[25], D, D, WO_T, 0, scr, r, lane); continue; } r -= 512;
            if (r < 128) { p0_transpose_item(args.in[28], D, 256, WR_T, 0, scr, r, lane); continue; } r -= 128;
            if (r < 128) { p0_transpose_item(args.in[33], D, 256, SH_GU_T, 0, scr, r, lane); continue; } r -= 128;
            if (r < 128) { p0_transpose_item(args.in[34], D, 256, SH_GU_T, 256, scr, r, lane); continue; } r -= 128;
            p0_transpose_item(args.in[35], 256, D, SH_D_T, 0, scr, r, lane);
        }
        for (size_t i = (size_t)gtid * 8; i < (size_t)T * D; i += (size_t)ngt * 8) { const f32x4 a = *(const f32x4*)(x + i), b = *(const f32x4*)(x + i + 4);
            v4u o; o.x = pk2(a[0], a[1]); o.y = pk2(a[2], a[3]); o.z = pk2(b[0], b[1]); o.w = pk2(b[2], b[3]); *(v4u*)(XB + i) = o; }
        for (size_t i = (size_t)gtid * 8; i < (size_t)NB * MEML * D; i += (size_t)ngt * 8) { const f32x4 a = *(const f32x4*)(args.in[1] + i), b = *(const f32x4*)(args.in[1] + i + 4);
            v4u o; o.x = pk2(a[0], a[1]); o.y = pk2(a[2], a[3]); o.z = pk2(b[0], b[1]); o.w = pk2(b[2], b[3]); *(v4u*)(MEMB + i) = o; }
        __syncthreads();
        for (int g = vcu; g < NG; g += G)
            p0_ssm_group(g, tid, lds, args.in[7], args.in[8], args.in[9], args.in[10], args.in[11], args.in[12], args.in[13], SSM_W1, SSM_W2, LAM16);
        if (BOTH(0)) GRID_BAR();
    }

    if (IN(1)) {
        ProjSched S{(const char*)XB, (const char*)W_IN_T, (const char*)MEMB, (const char*)WKV_T, G, bx};
        EpiProj E{CV, AS, KB, VT};
        pg8::gemm_phase<EpiProj, ProjSched, true>(lds, D, S, E);
        if (BOTH(1)) GRID_BAR();
    }

    if (IN(2)) {
        {
            LAS float* yl = (LAS float*)lds;
            const int c = tid;
            float wk[CW];
#pragma unroll
            for (int k = 0; k < CW; ++k) wk[k] = args.in[3][k * DC + c];
            const float cb = args.in[4][c];
            for (int u = vcu; u < T / 32; u += G) {
                const int t0 = u * 32, tl0 = t0 & (SEQ - 1);
                float win[CW];
#pragma unroll
                for (int k = 0; k < CW; ++k) win[k] = 0.f;
                for (int tt = -30; tt < 32; ++tt) {
                    float hv = 0.f;
                    if (tl0 + tt >= 0) { const size_t o = (size_t)(t0 + tt) * 1024 + c; const float v = bf2f(CV[o]), gt = bf2f(CV[o + 512]); hv = v * sigmoidf_(gt); }
#pragma unroll
                    for (int k = 0; k < CW - 1; ++k) win[k] = win[k + 1];
                    win[CW - 1] = hv;
                    if (tt >= 0) { float a = cb;
#pragma unroll
                        for (int k = 0; k < CW; ++k) a += wk[k] * win[k];
                        yl[tt * 512 + c] = a; }
                }
                __syncthreads();
                for (int r = wave; r < 32; r += NWAVES) {
                    float v[8]; float s = 0.f;
#pragma unroll
                    for (int j = 0; j < 8; ++j) { v[j] = yl[r * 512 + lane + 64 * j]; s += v[j]; }
                    const float mean = wave_sum(s) * (1.0f / 512.0f); float s2 = 0.f;
#pragma unroll
                    for (int j = 0; j < 8; ++j) { v[j] -= mean; s2 += v[j] * v[j]; }
                    const float rstd = 1.0f / sqrtf(wave_sum(s2) * (1.0f / 512.0f) + EPS); float s3 = 0.f;
#pragma unroll
                    for (int j = 0; j < 8; ++j) { const int cc = lane + 64 * j; float y = v[j] * rstd * args.in[5][cc] + args.in[6][cc]; y = y * sigmoidf_(y); v[j] = y; s3 += y * y; }
                    const float rr = 1.0f / sqrtf(wave_sum(s3) * (1.0f / 512.0f) + EPS);
#pragma unroll
                    for (int j = 0; j < 8; ++j) { const int cc = lane + 64 * j; MERGED[(size_t)(t0 + r) * 1024 + cc] = (bf16)f2bf(v[j] * rr * args.in[17][cc]); }
                }
                __syncthreads();
            }
        }
        {
            constexpr int TPG = (NCH / 64) * 2, TILES = NG * TPG;
            for (int t = gw; t < TILES; t += ngw) {
                const int g = t / TPG, q = t % TPG, m0 = (q >> 1) * 64, n0 = (q & 1) * 64;
                const bf16* ar[4]; const bf16* br[4];
#pragma unroll
                for (int i = 0; i < 4; ++i) { ar[i] = AS + ((size_t)(g * NCH + m0 + 16 * i + fr)) * 384 + fq * 8; br[i] = SSM_W1 + ((size_t)(g * 128 + n0 + 16 * i + fr)) * 256 + fq * 8; }
                f32x4 acc[4][4]; zero_acc(acc);
                wave_mma<4, 4>(ar, br, 256, acc);
#pragma unroll
                for (int i = 0; i < 4; ++i)
#pragma unroll
                    for (int j = 0; j < 4; ++j) *(f32x4*)(SEND + ((size_t)(g * NCH + m0 + 16 * i + fr)) * 128 + n0 + 16 * j + 4 * fq) = acc[i][j];
            }
        }
        if (BOTH(2)) GRID_BAR();
    }

    if (IN(3)) {
        if (gw < NG * NB) {
            const int g = gw >> 2, b = gw & 3, p = lane;
            const float lr = LAM16[(g * 64 + p) * 2], li = LAM16[(g * 64 + p) * 2 + 1];
            float sr = 0.f, si = 0.f;
            for (int c0 = 0; c0 < SEQ / LC; c0 += 8) {
                float er[8], ei[8];
#pragma unroll
                for (int q = 0; q < 8; ++q) { const size_t o = ((size_t)(g * NCH + b * 256 + c0 + q)) * 128 + p; er[q] = SEND[o]; ei[q] = SEND[o + 64]; }
#pragma unroll
                for (int q = 0; q < 8; ++q) { const size_t o = ((size_t)(g * NCH + b * 256 + c0 + q)) * 384 + 256 + p;
                    AS[o] = (bf16)f2bf(sr); AS[o + 64] = (bf16)f2bf(si);
                    const float nr = lr * sr - li * si + er[q], ni = lr * si + li * sr + ei[q]; sr = nr; si = ni; }
            }
        }
        if (BOTH(3)) GRID_BAR();
    }

    if (IN(4)) {
        constexpr int TPG = (NCH / 64) * 4, TILES = NG * TPG;
        for (int t = gw; t < TILES; t += ngw) {
            const int g = t / TPG, q = t % TPG, m0 = (q >> 2) * 64, n0 = (q & 3) * 64;
            const bf16* ar[4]; const bf16* br[4];
#pragma unroll
            for (int i = 0; i < 4; ++i) { ar[i] = AS + ((size_t)(g * NCH + m0 + 16 * i + fr)) * 384 + fq * 8; br[i] = SSM_W2 + ((size_t)(g * 256 + n0 + 16 * i + fr)) * 384 + fq * 8; }
            f32x4 acc[4][4]; zero_acc(acc);
            wave_mma<4, 4>(ar, br, 384, acc);
#pragma unroll
            for (int i = 0; i < 4; ++i)
#pragma unroll
                for (int j = 0; j < 4; ++j) { const int r = m0 + 16 * i + fr, n = n0 + 16 * j + 4 * fq, ti = n >> 4, h = n & 15;
                    const v2u uu = *(const v2u*)(AS + ((size_t)(g * NCH + r)) * 384 + n);
                    const f32x4 dd = *(const f32x4*)(args.in[14] + g * 16 + h);
                    const float y0 = acc[i][j][0] + dd[0] * bflo(uu.x), y1 = acc[i][j][1] + dd[1] * bfhi(uu.x), y2 = acc[i][j][2] + dd[2] * bflo(uu.y), y3 = acc[i][j][3] + dd[3] * bfhi(uu.y);
                    v2u w; w.x = pk2(gelu_tanh(y0), gelu_tanh(y1)); w.y = pk2(gelu_tanh(y2), gelu_tanh(y3));
                    *(v2u*)(Z + ((size_t)(r * 16 + ti)) * 512 + g * 16 + h) = w; }
        }
        if (BOTH(4)) GRID_BAR();
    }

    if (IN(5)) {
        constexpr int NT = 512 / 64, TILES = (T / 64) * NT;
        for (int t = gw; t < TILES; t += ngw) {
            const int m0 = (t / NT) * 64, n0 = (t % NT) * 64;
            const bf16* ar[4]; const bf16* br[4];
#pragma unroll
            for (int i = 0; i < 4; ++i) { ar[i] = Z + (size_t)(m0 + 16 * i + fr) * 512 + fq * 8; br[i] = W_GLU_T + (size_t)(n0 + 16 * i + fr) * 512 + fq * 8; }
            f32x4 acc[4][4]; zero_acc(acc);
            wave_mma<4, 4>(ar, br, 512, acc);
#pragma unroll
            for (int i = 0; i < 4; ++i)
#pragma unroll
                for (int j = 0; j < 4; ++j) { const int m = m0 + 16 * i + fr, n = n0 + 16 * j + 4 * fq;
                    const v2u zz = *(const v2u*)(Z + (size_t)m * 512 + n); const f32x4 bg = *(const f32x4*)(args.in[16] + n);
                    f32x4 o; o[0] = bflo(zz.x) * sigmoidf_(acc[i][j][0] + bg[0]); o[1] = bfhi(zz.x) * sigmoidf_(acc[i][j][1] + bg[1]);
                    o[2] = bflo(zz.y) * sigmoidf_(acc[i][j][2] + bg[2]); o[3] = bfhi(zz.y) * sigmoidf_(acc[i][j][3] + bg[3]);
                    *(f32x4*)(ZG + (size_t)m * 512 + n) = o; }
        }
        if (BOTH(5)) GRID_BAR();
    }

    if (IN(6)) {
        for (int m = gw; m < T; m += ngw) {
            const f32x4 a = *(const f32x4*)(ZG + (size_t)m * 512 + lane * 4), b = *(const f32x4*)(ZG + (size_t)m * 512 + 256 + lane * 4);
            float s = (a[0] * a[0] + a[1] * a[1]) + (a[2] * a[2] + a[3] * a[3]) + (b[0] * b[0] + b[1] * b[1]) + (b[2] * b[2] + b[3] * b[3]);
            const float rr = 1.0f / sqrtf(wave_sum(s) * (1.0f / 512.0f) + EPS);
            const f32x4 ga = *(const f32x4*)(args.in[18] + lane * 4), gb = *(const f32x4*)(args.in[18] + 256 + lane * 4);
            v2u w; w.x = pk2(a[0] * rr * ga[0], a[1] * rr * ga[1]); w.y = pk2(a[2] * rr * ga[2], a[3] * rr * ga[3]);
            *(v2u*)(MERGED + (size_t)m * 1024 + 512 + lane * 4) = w;
            w.x = pk2(b[0] * rr * gb[0], b[1] * rr * gb[1]); w.y = pk2(b[2] * rr * gb[2], b[3] * rr * gb[3]);
            *(v2u*)(MERGED + (size_t)m * 1024 + 768 + lane * 4) = w;
        }
        if (BOTH(6)) GRID_BAR();
    }

#define GEMM_D_D(Aptr, Btptr, ...) do { \
        constexpr int NT = D / 64, TILES = (T / 64) * NT; \
        for (int t = gw; t < TILES; t += ngw) { \
            const int m0 = (t / NT) * 64, n0 = (t % NT) * 64; \
            const bf16* ar[4]; const bf16* br[4]; \
            _Pragma("unroll") for (int i = 0; i < 4; ++i) { ar[i] = (Aptr) + (size_t)(m0 + 16 * i + fr) * D + fq * 8; br[i] = (Btptr) + (size_t)(n0 + 16 * i + fr) * D + fq * 8; } \
            f32x4 acc[4][4]; zero_acc(acc); \
            wave_mma<4, 4>(ar, br, D, acc); \
            _Pragma("unroll") for (int i = 0; i < 4; ++i) _Pragma("unroll") for (int j = 0; j < 4; ++j) { const int m = m0 + 16 * i + fr, n = n0 + 16 * j + 4 * fq; const f32x4 v = acc[i][j]; __VA_ARGS__ } \
        } } while (0)

#define LN_ROWS(SRC, GAIN, BIAS, DSTF, DSTB) do { \
        for (int m = gw; m < T; m += ngw) { \
            f32x4 v[4]; float s = 0.f; \
            _Pragma("unroll") for (int j = 0; j < 4; ++j) { v[j] = *(const f32x4*)((SRC) + (size_t)m * D + j * 256 + lane * 4); s += (v[j][0] + v[j][1]) + (v[j][2] + v[j][3]); } \
            const float mean = wave_sum(s) * (1.0f / D); float s2 = 0.f; \
            _Pragma("unroll") for (int j = 0; j < 4; ++j) { v[j] = v[j] - mean; s2 += (v[j][0] * v[j][0] + v[j][1] * v[j][1]) + (v[j][2] * v[j][2] + v[j][3] * v[j][3]); } \
            const float rstd = 1.0f / sqrtf(wave_sum(s2) * (1.0f / D) + EPS); \
            _Pragma("unroll") for (int j = 0; j < 4; ++j) { const f32x4 gg = *(const f32x4*)((GAIN) + j * 256 + lane * 4), bb = *(const f32x4*)((BIAS) + j * 256 + lane * 4); \
                const f32x4 o = v[j] * rstd * gg + bb; *(f32x4*)((DSTF) + (size_t)m * D + j * 256 + lane * 4) = o; \
                if ((DSTB) != nullptr) { v2u w; w.x = pk2(o[0], o[1]); w.y = pk2(o[2], o[3]); *(v2u*)((DSTB) + (size_t)m * D + j * 256 + lane * 4) = w; } } \
        } } while (0)

    if (IN(7)) {
        pg8::DenseSched S; S.init(MERGED, W_OUT_T, T, D, D, G, bx);
        EpiResF32 E{x, Y1};
        pg8::gemm_phase<EpiResF32, pg8::DenseSched, false>(lds, D, S, E);
        if (BOTH(7)) GRID_BAR();
    }
    if (IN(8)) {
        LN_ROWS(Y1, args.in[20], args.in[21], X1, X1B);
        if (BOTH(8)) GRID_BAR();
    }
    if (IN(9)) {
        pg8::DenseSched S; S.init(X1B, WQ_T, T, D, D, G, bx);
        EpiBf16S E{Q, 0.0625f};
        pg8::gemm_phase<EpiBf16S, pg8::DenseSched, false>(lds, D, S, E);
        if (BOTH(9)) GRID_BAR();
    }
    if (IN(10)) {
        for (int u = gw; u < NB * NXH * (SEQ / 16); u += ngw) {
            const int bh = u / (SEQ / 16), qt = u % (SEQ / 16), b = bh >> 2, h = bh & 3;
            const bf16* qrow = Q + (size_t)(b * SEQ + qt * 16 + fr) * D + h * XHD + fq * 8;
            bf16x8 qf[8];
#pragma unroll
            for (int ks = 0; ks < 8; ++ks) qf[ks] = *(const bf16x8*)(qrow + ks * 32);
            f32x4 s[16];
#pragma unroll
            for (int nt = 0; nt < 16; ++nt) { s[nt] = (f32x4){0.f, 0.f, 0.f, 0.f};
                const bf16* krow = KB + (size_t)(b * MEML + nt * 16 + fr) * D + h * XHD + fq * 8;
#pragma unroll
                for (int ks = 0; ks < 8; ++ks) { const bf16x8 kf = *(const bf16x8*)(krow + ks * 32); s[nt] = __builtin_amdgcn_mfma_f32_16x16x32_bf16(kf, qf[ks], s[nt], 0, 0, 0); } }
            float mx = -3.0e38f;
#pragma unroll
            for (int nt = 0; nt < 16; ++nt) mx = fmaxf(mx, fmaxf(fmaxf(s[nt][0], s[nt][1]), fmaxf(s[nt][2], s[nt][3])));
            mx = fmaxf(mx, __shfl_xor(mx, 16)); mx = fmaxf(mx, __shfl_xor(mx, 32));
            float sum = 0.f;
#pragma unroll
            for (int nt = 0; nt < 16; ++nt) {
#pragma unroll
                for (int r = 0; r < 4; ++r) { const float e = __expf(s[nt][r] - mx); s[nt][r] = e; sum += e; } }
            sum += __shfl_xor(sum, 16); sum += __shfl_xor(sum, 32);
            const float inv = 1.0f / sum;
            bf16x8 pf[8];
#pragma unroll
            for (int ks = 0; ks < 8; ++ks) { v4u w; w.x = pk2(s[2 * ks][0] * inv, s[2 * ks][1] * inv); w.y = pk2(s[2 * ks][2] * inv, s[2 * ks][3] * inv);
                w.z = pk2(s[2 * ks + 1][0] * inv, s[2 * ks + 1][1] * inv); w.w = pk2(s[2 * ks + 1][2] * inv, s[2 * ks + 1][3] * inv); pf[ks] = __builtin_bit_cast(bf16x8, w); }
            bf16* orow = O + (size_t)(b * SEQ + qt * 16 + fr) * D + h * XHD + 4 * fq;
#pragma unroll
            for (int dt = 0; dt < 16; ++dt) { f32x4 o = (f32x4){0.f, 0.f, 0.f, 0.f};
                const bf16* vrow = VT + ((size_t)(b * 1024 + h * XHD + dt * 16 + fr)) * 256 + 4 * fq;
#pragma unroll
                for (int ks = 0; ks < 8; ++ks) { const v2u lo2 = *(const v2u*)(vrow + ks * 32), hi2 = *(const v2u*)(vrow + ks * 32 + 16);
                    v4u w; w.x = lo2.x; w.y = lo2.y; w.z = hi2.x; w.w = hi2.y;
                    o = __builtin_amdgcn_mfma_f32_16x16x32_bf16(__builtin_bit_cast(bf16x8, w), pf[ks], o, 0, 0, 0); }
                v2u w; w.x = pk2(o[0], o[1]); w.y = pk2(o[2], o[3]); *(v2u*)(orow + dt * 16) = w; }
        }
        if (BOTH(10)) GRID_BAR();
    }
    if (IN(11)) {
        pg8::DenseSched S; S.init(O, WO_T, T, D, D, G, bx);
        EpiResF32 E{X1, Y1};
        pg8::gemm_phase<EpiResF32, pg8::DenseSched, false>(lds, D, S, E);
        if (BOTH(11)) GRID_BAR();
    }
    if (IN(12)) {
        LN_ROWS(Y1, args.in[26], args.in[27], X2, X2B);
        if (BOTH(12)) GRID_BAR();
    }
    if (IN(13)) {
        constexpr int NT = NE / 64, TILES = (T / 64) * NT;
        for (int t = gw; t < TILES; t += ngw) {
            const int m0 = (t / NT) * 64, n0 = (t % NT) * 64;
            const bf16* ar[4]; const bf16* br[4];
#pragma unroll
            for (int i = 0; i < 4; ++i) { ar[i] = X2B + (size_t)(m0 + 16 * i + fr) * D + fq * 8; br[i] = WR_T + (size_t)(n0 + 16 * i + fr) * D + fq * 8; }
            f32x4 acc[4][4]; zero_acc(acc);
            wave_mma<4, 4>(ar, br, D, acc);
#pragma unroll
            for (int i = 0; i < 4; ++i)
#pragma unroll
                for (int j = 0; j < 4; ++j) *(f32x4*)(LOGITS + (size_t)(m0 + 16 * i + fr) * NE + n0 + 16 * j + 4 * fq) = acc[i][j];
        }
        if (BOTH(13)) GRID_BAR();
    }
    if (IN(14)) {
        const f32x4 rb = *(const f32x4*)(args.in[29] + lane * 4);
        for (int m = gw; m < T; m += ngw) {
            const f32x4 lg = *(const f32x4*)(LOGITS + (size_t)m * NE + lane * 4);
            float sc[4], bs[4];
#pragma unroll
            for (int r = 0; r < 4; ++r) { sc[r] = sigmoidf_(lg[r]); bs[r] = sc[r] + rb[r]; }
            float m1 = fmaxf(bs[0], bs[1]), m2 = fminf(bs[0], bs[1]);
            { const float a = bs[2]; const float n1 = fmaxf(m1, a); m2 = fmaxf(m2, fminf(m1, a)); m1 = n1; }
            { const float a = bs[3]; const float n1 = fmaxf(m1, a); m2 = fmaxf(m2, fminf(m1, a)); m1 = n1; }
#pragma unroll
            for (int o = 1; o < 8; o <<= 1) { const float o1 = __shfl_xor(m1, o), o2 = __shfl_xor(m2, o); const float n1 = fmaxf(m1, o1); m2 = fmaxf(fminf(m1, o1), fmaxf(m2, o2)); m1 = n1; }
            const float gs = m1 + m2; const int myg = lane >> 3;
            int rank = 0;
#pragma unroll
            for (int g2 = 0; g2 < 8; ++g2) { const float og = __shfl(gs, g2 * 8); rank += (og > gs || (og == gs && g2 < myg)) ? 1 : 0; }
            const bool sel = rank < TKG;
            float mv[4];
#pragma unroll
            for (int r = 0; r < 4; ++r) mv[r] = sel ? bs[r] : -3.0e38f;
            int my_e = 0; float my_sc = 0.f; float gsum = 0.f;
#pragma unroll
            for (int k = 0; k < TOPK; ++k) {
                float bv = mv[0]; int bi = 0;
#pragma unroll
                for (int r = 1; r < 4; ++r) if (mv[r] > bv) { bv = mv[r]; bi = r; }
                int be = lane * 4 + bi;
#pragma unroll
                for (int o = 1; o < 64; o <<= 1) { const float ov = __shfl_xor(bv, o); const int oe = __shfl_xor(be, o); if (ov > bv || (ov == bv && oe < be)) { bv = ov; be = oe; } }
                const int wl = be >> 2, wr_ = be & 3;
                float wsc = (wr_ == 0) ? sc[0] : (wr_ == 1) ? sc[1] : (wr_ == 2) ? sc[2] : sc[3];
                wsc = __shfl(wsc, wl);
                if (lane == wl) {
#pragma unroll
                    for (int r = 0; r < 4; ++r) if (r == wr_) mv[r] = -3.0e38f; }
                gsum += wsc;
                if (lane == k) { my_e = be; my_sc = wsc; }
            }
            if (lane < TOPK) { const unsigned pos = __hip_atomic_fetch_add(CNT + my_e, 1u, RLX_AGENT);
                TOPE[m * 8 + lane] = my_e; TOPP[m * 8 + lane] = (int)pos; GATE[m * 8 + lane] = ROUTED_SCALE * my_sc / gsum; }
        }
        if (BOTH(14)) GRID_BAR();
    }
#define MOE_OFFSETS() LAS int* off = (LAS int*)(lds + 132096); LAS int* tst = off + 260; \
        __syncthreads(); \
        if (tid < 64) { int c4[4]; int s = 0, s2 = 0; \
            _Pragma("unroll") for (int r = 0; r < 4; ++r) { c4[r] = (int)__hip_atomic_load(CNT + tid * 4 + r, RLX_AGENT); s += c4[r]; s2 += (c4[r] + 255) >> 8; } \
            int ps = s, ps2 = s2; \
            _Pragma("unroll") for (int o = 1; o < 64; o <<= 1) { const int a = __shfl_up(ps, o), a2 = __shfl_up(ps2, o); if (lane >= o) { ps += a; ps2 += a2; } } \
            int e0 = ps - s, t0 = ps2 - s2; \
            _Pragma("unroll") for (int r = 0; r < 4; ++r) { off[tid * 4 + r] = e0; tst[tid * 4 + r] = t0; e0 += c4[r]; t0 += (c4[r] + 255) >> 8; } \
            if (tid == 63) { off[256] = e0; tst[256] = t0; } } \
        __syncthreads();

    if (IN(15)) {
        MOE_OFFSETS();
        for (int a = gtid; a < NASSIGN; a += ngt) { const int e = TOPE[a], sl = off[e] + TOPP[a]; SLOT[a] = sl; STOK[sl] = a >> 3; SGATE[sl] = GATE[a]; }
        for (int t = gtid; t < T; t += ngt) STOK[NASSIGN + t] = t;
        if (BOTH(15)) GRID_BAR();
    }
    if (IN(16)) {
        MOE_OFFSETS();
        const int nmoe = tst[256];
        MoeSched<true> S{X2B, X2B, WGU_T, SH_GU_T, STOK, off, tst, nmoe, (nmoe + T / 256) * 2, G, bx, lds + 135168};
        EpiGateUp E{H, HS};
        pg8::gemm_phase<EpiGateUp, MoeSched<true>, true>(lds, D, S, E);
        if (BOTH(16)) GRID_BAR();
    }
    if (IN(17)) {
        MOE_OFFSETS();
        const int nmoe = tst[256];
        MoeSched<false> S{H, HS, WD_T, SH_D_T, STOK, off, tst, nmoe, (nmoe + T / 256) * 4, G, bx, lds + 135168};
        EpiDown E{Y, YS, SGATE};
        pg8::gemm_phase<EpiDown, MoeSched<false>, true>(lds, DE, S, E);
        if (BOTH(17)) GRID_BAR();
    }
    if (IN(18)) {
        for (int m = gw; m < T; m += ngw) {
            f32x4 v[4];
#pragma unroll
            for (int j = 0; j < 4; ++j) { v[j] = *(const f32x4*)(X2 + (size_t)m * D + j * 256 + lane * 4) * ALPHA;
                const v2u ys = *(const v2u*)(YS + (size_t)m * D + j * 256 + lane * 4); v[j][0] += bflo(ys.x); v[j][1] += bfhi(ys.x); v[j][2] += bflo(ys.y); v[j][3] += bfhi(ys.y); }
#pragma unroll
            for (int k = 0; k < TOPK; ++k) { const int sl = SLOT[m * 8 + k];
#pragma unroll
                for (int j = 0; j < 4; ++j) { const v2u yy = *(const v2u*)(Y + (size_t)sl * D + j * 256 + lane * 4); v[j][0] += bflo(yy.x); v[j][1] += bfhi(yy.x); v[j][2] += bflo(yy.y); v[j][3] += bfhi(yy.y); } }
            float s = 0.f;
#pragma unroll
            for (int j = 0; j < 4; ++j) s += (v[j][0] + v[j][1]) + (v[j][2] + v[j][3]);
            const float mean = wave_sum(s) * (1.0f / D); float s2 = 0.f;
#pragma unroll
            for (int j = 0; j < 4; ++j) { v[j] = v[j] - mean; s2 += (v[j][0] * v[j][0] + v[j][1] * v[j][1]) + (v[j][2] * v[j][2] + v[j][3] * v[j][3]); }
            const float rstd = 1.0f / sqrtf(wave_sum(s2) * (1.0f / D) + EPS);
#pragma unroll
            for (int j = 0; j < 4; ++j) { const f32x4 gg = *(const f32x4*)(args.in[36] + j * 256 + lane * 4), bb = *(const f32x4*)(args.in[37] + j * 256 + lane * 4);
                *(f32x4*)(args.out + (size_t)m * D + j * 256 + lane * 4) = v[j] * rstd * gg + bb; }
        }
    }
#undef IN
#undef BOTH
}

extern "C" void kernel_launch(void* const* d_in, const int* in_sizes, int n_in, void* d_out, int out_size, void* d_ws, size_t ws_size, hipStream_t stream) {
    static int grid = 0;
    if (grid == 0) {
        if (n_in != 38 || out_size != T * D || ws_size < WS_END) { fprintf(stderr, "kernel_launch: unexpected shapes (n_in %d, out %d, ws %zu)\n", n_in, out_size, ws_size); grid = -1; return; }
        int dev = 0, cus = 0, per_cu = 0;
        if (hipGetDevice(&dev) != hipSuccess || hipDeviceGetAttribute(&cus, hipDeviceAttributeMultiprocessorCount, dev) != hipSuccess) { grid = -1; return; }
        if (hipFuncSetAttribute((const void*)fwd, hipFuncAttributeMaxDynamicSharedMemorySize, LDS_BYTES) != hipSuccess) { fprintf(stderr, "kernel_launch: hipFuncSetAttribute failed\n"); grid = -1; return; }
        if (hipOccupancyMaxActiveBlocksPerMultiprocessor(&per_cu, (const void*)fwd, NTHR, LDS_BYTES) != hipSuccess || per_cu < 1) { fprintf(stderr, "kernel_launch: occupancy query says %d\n", per_cu); }
        (void)hipGetLastError();
        grid = cus;
    }
    if (grid < 0) return;
    (void)hipMemsetAsync((char*)d_ws + WS_CTL, 0, CTL_ZERO_BYTES, stream);
    Args a{};
    for (int i = 0; i < 38; ++i) a.in[i] = (const float*)d_in[i];
    a.out = (float*)d_out; a.ws = (unsigned char*)d_ws;
#if MK_SPLIT
    for (int p = 0; p < N_PHASES; ++p) { a.ph_lo = p; a.ph_hi = p + 1; hipLaunchKernelGGL(fwd, dim3(grid), dim3(NTHR), LDS_BYTES, stream, a); }
#else
    a.ph_lo = 0; a.ph_hi = N_PHASES;
    hipLaunchKernelGGL(fwd, dim3(grid), dim3(NTHR), LDS_BYTES, stream, a);
#endif
}
```

```cpp
#include <hip/hip_runtime.h>
#include <cstdio>
#include <cstdint>

#ifndef MK_SPLIT
#define MK_SPLIT 0
#endif

#define GAS __attribute__((address_space(1)))
#define LAS __attribute__((address_space(3)))
typedef unsigned short bf16;
typedef short bf16x8 __attribute__((ext_vector_type(8)));
typedef float f32x4 __attribute__((ext_vector_type(4)));
typedef unsigned v4u __attribute__((ext_vector_type(4)));
typedef unsigned v2u __attribute__((ext_vector_type(2)));
#define RLX_AGENT __ATOMIC_RELAXED, __HIP_MEMORY_SCOPE_AGENT
#define LDS_WAIT() asm volatile("s_waitcnt lgkmcnt(0)" ::: "memory")

constexpr int NB = 4, SEQ = 4096, T = NB * SEQ, D = 1024;
constexpr int DC = 512, DS = 512, CW = 31, NG = 32, GH = 16, PS = 64;
constexpr int LC = 16, NCH = T / LC;
constexpr int MEML = 256, NXH = 4, XHD = 256;
constexpr int NE = 256, TOPK = 8, NEG = 8, TKG = 4, DE = 256;
constexpr int NASSIGN = T * TOPK;
constexpr float ALPHA = 1.189207115002721f;
constexpr float EPS = 1e-5f;
constexpr float ROUTED_SCALE = 2.5f;
constexpr int NWAVES = 8, NTHR = 512;

constexpr size_t MiB = 1u << 20;
constexpr size_t WS_CTL = 0, CTL_ZERO_BYTES = 1 * MiB;
constexpr size_t WS_W_IN_T = 1 * MiB;
constexpr size_t WS_W_GLU_T = 4 * MiB;
constexpr size_t WS_W_OUT_T = 5 * MiB;
constexpr size_t WS_WQ_T = 7 * MiB;
constexpr size_t WS_WKV_T = 9 * MiB;
constexpr size_t WS_WO_T = 13 * MiB;
constexpr size_t WS_WR_T = 15 * MiB;
constexpr size_t WS_SSM_W1 = 16 * MiB;
constexpr size_t WS_SSM_W2 = 18 * MiB;
constexpr size_t WS_SH_GU_T = 24 * MiB;
constexpr size_t WS_SH_D_T = 25 * MiB;
constexpr size_t WS_LAM16 = 25 * MiB + 512 * 1024;
constexpr size_t WS_MEMB = 26 * MiB;
constexpr size_t WS_KB = 28 * MiB;
constexpr size_t WS_VT = 30 * MiB;
constexpr size_t WS_WGU_T = 32 * MiB;
constexpr size_t WS_WD_T = 288 * MiB;
constexpr size_t WS_X2 = 416 * MiB;
constexpr size_t WS_X2B = 480 * MiB;
constexpr size_t WS_Y = 512 * MiB;
constexpr size_t WS_XB = 512 * MiB;
constexpr size_t WS_CV = 544 * MiB;
constexpr size_t WS_AS = 576 * MiB;
constexpr size_t WS_SEND = 600 * MiB;
constexpr size_t WS_Z = 616 * MiB;
constexpr size_t WS_ZG = 632 * MiB;
constexpr size_t WS_MERGED = 664 * MiB;
constexpr size_t WS_Y1 = 696 * MiB;
constexpr size_t WS_H = 768 * MiB;
constexpr size_t WS_Q = 768 * MiB;
constexpr size_t WS_O = 800 * MiB;
constexpr size_t WS_X1 = 832 * MiB;
constexpr size_t WS_X1B = 896 * MiB;
constexpr size_t WS_YS = 840 * MiB;
constexpr size_t WS_HS = 832 * MiB;
constexpr size_t WS_LOGITS = 872 * MiB;
constexpr size_t WS_TOPE = 928 * MiB;
constexpr size_t WS_TOPP = 928 * MiB + 512 * 1024;
constexpr size_t WS_GATE = 929 * MiB;
constexpr size_t WS_SLOT = 929 * MiB + 512 * 1024;
constexpr size_t WS_STOK = 930 * MiB;
constexpr size_t WS_SGATE = 931 * MiB;
constexpr size_t WS_END = 932 * MiB;
static_assert(WS_HS == WS_H + (size_t)NASSIGN * 256 * 2, "HS follows H");
constexpr int CW_BAR = 4096;
constexpr int CW_CNT = 16384;

constexpr int LDS_BYTES = 147456;
constexpr int MISC_OFF = 131072 + 320;

__device__ __forceinline__ unsigned f2bf(float f) { unsigned u = __builtin_bit_cast(unsigned, f); return (u + 0x7fffu + ((u >> 16) & 1u)) >> 16; }
__device__ __forceinline__ unsigned pk2(float lo, float hi) { return f2bf(lo) | (f2bf(hi) << 16); }
__device__ __forceinline__ float bf2f(unsigned h) { return __builtin_bit_cast(float, h << 16); }
__device__ __forceinline__ float bflo(unsigned w) { return __builtin_bit_cast(float, w << 16); }
__device__ __forceinline__ float bfhi(unsigned w) { return __builtin_bit_cast(float, w & 0xffff0000u); }
__device__ __forceinline__ float sigmoidf_(float x) { return __builtin_amdgcn_rcpf(1.0f + __expf(-x)); }
__device__ __forceinline__ float wave_sum(float v) {
#pragma unroll
    for (int o = 1; o < 64; o <<= 1) v += __shfl_xor(v, o);
    return v;
}
__device__ __forceinline__ float gelu_tanh(float x) {
    const float u = 0.7978845608028654f * (x + 0.044715f * x * x * x);
    const float t = 1.0f - 2.0f / (1.0f + __expf(2.0f * u));
    return 0.5f * x * (1.0f + t);
}

#define XB_TMO      128
#define XB_XCNT(j)  (256  + 64 * (j))
#define XB_XSUB(j)  (1280 + 64 * (j))
#define XB_XGEN(j)  (2304 + 64 * (j))
#define XB_TOP      3328
#define XB_TOPGEN   3392
#define XCD_BAR_WORDS 3456
#define XB_SPIN_CAP (1u << 20)

__device__ __forceinline__ unsigned xb_ld(unsigned* p)              { return __hip_atomic_load(p, __ATOMIC_RELAXED, __HIP_MEMORY_SCOPE_AGENT); }
__device__ __forceinline__ unsigned xb_add(unsigned* p, unsigned v) { return __hip_atomic_fetch_add(p, v, __ATOMIC_RELAXED, __HIP_MEMORY_SCOPE_AGENT); }
__device__ __forceinline__ unsigned xb_xcc_id() { return (unsigned)__builtin_amdgcn_s_getreg((3 << 11) | 20) & 0xFu; }
#define XB_SPIN(cond, bar) do { unsigned _sp = 0; while (cond) { __builtin_amdgcn_s_sleep(1); \
    if ((++_sp & 255u) == 0u) { if (xb_ld(&(bar)[XB_TMO])) break; if (_sp > XB_SPIN_CAP) { atomicAdd(&(bar)[XB_TMO], 1u); break; } } } } while (0)

struct XcdBarrier { unsigned* bar; unsigned x; volatile LAS unsigned* st; };

__device__ __forceinline__ XcdBarrier xcd_barrier_post(unsigned* bar, volatile LAS unsigned* st) {
    XcdBarrier b; b.bar = bar; b.x = xb_xcc_id(); b.st = st;
    if (threadIdx.x == 0) (void)xb_add(&bar[XB_XCNT(b.x)], 1u);
    return b;
}
__device__ __forceinline__ void xcd_barrier_complete(unsigned* bar, unsigned x, unsigned& nloc, unsigned& nx) {
    const unsigned G = gridDim.x * gridDim.y * gridDim.z;
    unsigned sum, cnt, mine, sp = 0u;
    for (;;) {
        sum = 0u; cnt = 0u; mine = 0u;
#pragma unroll
        for (unsigned j = 0; j < 16; ++j) { const unsigned c = xb_ld(&bar[XB_XCNT(j)]); sum += c; cnt += (c > 0u) ? 1u : 0u; mine = (j == x) ? c : mine; }
        if (sum == G) break;
        __builtin_amdgcn_s_sleep(1);
        if ((++sp & 255u) == 0u) { if (xb_ld(&bar[XB_TMO])) break; if (sp > XB_SPIN_CAP) { atomicAdd(&bar[XB_TMO], 1u); break; } }
    }
    nloc = mine > 0u ? mine : 1u; nx = cnt > 0u ? cnt : 1u;
}
__device__ __forceinline__ void xcd_barrier(const XcdBarrier& b) {
    asm volatile("s_waitcnt vmcnt(0)" ::: "memory");
    __syncthreads();
    if (threadIdx.x == 0) {
        unsigned* bar = b.bar;
        __builtin_amdgcn_s_waitcnt(0);
        unsigned nloc = b.st[0], nx = b.st[1];
        if (nloc == 0u) { xcd_barrier_complete(bar, b.x, nloc, nx); b.st[0] = nloc; b.st[1] = nx; }
        const unsigned old = xb_add(&bar[XB_XSUB(b.x)], 1u);
        const unsigned gen = old / nloc;
        if (old + 1u == (gen + 1u) * nloc) {
            __builtin_amdgcn_fence(__ATOMIC_RELEASE, "agent");
            asm volatile("s_waitcnt vmcnt(0)" ::: "memory");
            const unsigned og = xb_add(&bar[XB_TOP], 1u);
            const unsigned tg = og / nx;
            if (og + 1u == (tg + 1u) * nx) xb_add(&bar[XB_TOPGEN], 1u);
            else XB_SPIN(xb_ld(&bar[XB_TOPGEN]) == tg, bar);
            __builtin_amdgcn_fence(__ATOMIC_ACQUIRE, "agent");
            xb_add(&bar[XB_XGEN(b.x)], 1u);
            asm volatile("s_waitcnt vmcnt(0)" ::: "memory");
        } else {
            XB_SPIN(xb_ld(&bar[XB_XGEN(b.x)]) == gen, bar);
            __builtin_amdgcn_fence(__ATOMIC_ACQUIRE, "agent");
            asm volatile("s_waitcnt vmcnt(0)" ::: "memory");
        }
    }
    __syncthreads();
}

template <int MI, int NJ>
__device__ __forceinline__ void wave_mma(const bf16* (&ar)[MI], const bf16* (&br)[NJ], int K, f32x4 (&acc)[MI][NJ]) {
#pragma unroll 2
    for (int k = 0; k < K; k += 32) {
        bf16x8 a[MI], b[NJ];
#pragma unroll
        for (int i = 0; i < MI; ++i) a[i] = *(const bf16x8*)(ar[i] + k);
#pragma unroll
        for (int j = 0; j < NJ; ++j) b[j] = *(const bf16x8*)(br[j] + k);
#pragma unroll
        for (int i = 0; i < MI; ++i)
#pragma unroll
            for (int j = 0; j < NJ; ++j) acc[i][j] = __builtin_amdgcn_mfma_f32_16x16x32_bf16(b[j], a[i], acc[i][j], 0, 0, 0);
    }
}
template <int MI, int NJ>
__device__ __forceinline__ void zero_acc(f32x4 (&acc)[MI][NJ]) {
#pragma unroll
    for (int i = 0; i < MI; ++i)
#pragma unroll
        for (int j = 0; j < NJ; ++j) acc[i][j] = (f32x4){0.f, 0.f, 0.f, 0.f};
}


namespace pg8 {
constexpr int BM = 256, BK = 64, HALF = 128, HTB = HALF * BK * 2, STAGE_BYTES = 8 * HTB, NXCD = 8, WGM = 8;
__host__ __device__ __forceinline__ int lds_byte(int r, int c) { const int st = (r >> 4) * 2 + (c >> 5), rr = r & 15, cc = c & 31, ob = rr * 64 + cc * 2; return st * 1024 + (ob ^ (((ob >> 9) & 1) << 5)); }
__host__ __device__ __forceinline__ void stage_rc(int b, int& R, int& C) { const int st = b / 1024, sb = b % 1024, swz = sb ^ (((sb >> 9) & 1) << 5); R = (st >> 1) * 16 + swz / 64; C = (st & 1) * 32 + (swz % 64) / 2; }
__host__ __device__ __forceinline__ int perm32(int rho) { const int n = rho >> 4, i = rho & 15; return 8 * (i >> 2) + 4 * n + (i & 3); }
__device__ __forceinline__ unsigned cvt_pk_bf16(float lo, float hi) { unsigned r; asm volatile("v_cvt_pk_bf16_f32 %0, %1, %2" : "=v"(r) : "v"(lo), "v"(hi)); return r; }

struct Unit { int pm, pn, e, base, cnt; };

template <class Epi, class Sched, bool ALIGN_EPI>
__device__ __forceinline__ void gemm_phase(LAS unsigned char* lds, const int K, const Sched& S, const Epi& E) {
    const int tid = threadIdx.x, wid = __builtin_amdgcn_readfirstlane(tid >> 6), lane = tid & 63, wr = wid >> 2, wc = wid & 3, fr = lane & 15, fq = lane >> 4;
    const int nt = K / BK;
    unsigned voffB[2];
#pragma unroll
    for (int i = 0; i < 2; ++i) { int R, C; stage_rc(tid * 16 + i * 8192, R, C); const int Rb = Epi::PERM ? ((R & ~31) + perm32(R & 31)) : R; voffB[i] = (unsigned)(Rb * K + C) * 2u; }
    const size_t kstep = (size_t)(BK * 2);
    const size_t hB = S.b_hstep(K);
    const unsigned ldsw = (unsigned)wid * 1024u;
    const int aoff = lds_byte(wr * 64 + fr, fq * 8), boff = lds_byte(wc * 32 + fr, fq * 8);
#define PG8_SA(b, h) (((b) * 2 + (h)) * HTB)
#define PG8_SB(b, h) ((4 + (b) * 2 + (h)) * HTB)
#define PG8_STAGE(bufoff, gbase, voff) do { _Pragma("unroll") for (int _i = 0; _i < 2; ++_i) \
        __builtin_amdgcn_global_load_lds((const unsigned*)((const char*)(gbase) + (voff)[_i]), (LAS unsigned*)(lds + (bufoff) + ldsw + _i * 8192), 16, 0, 0); } while (0)
#define PG8_LDA(dst, b, h) do { _Pragma("unroll") for (int m = 0; m < 4; ++m) _Pragma("unroll") for (int k = 0; k < 2; ++k) dst[m][k] = *(const LAS bf16x8*)(lds + PG8_SA(b, h) + aoff + m * 2048 + k * 1024); } while (0)
#define PG8_LDB(dst, b, h) do { _Pragma("unroll") for (int n = 0; n < 2; ++n) _Pragma("unroll") for (int k = 0; k < 2; ++k) dst[n][k] = *(const LAS bf16x8*)(lds + PG8_SB(b, h) + boff + n * 2048 + k * 1024); } while (0)
#define PG8_MMA(ai, bj, At, Bt) do { __builtin_amdgcn_s_setprio(1); _Pragma("unroll") for (int m = 0; m < 4; ++m) _Pragma("unroll") for (int n = 0; n < 2; ++n) _Pragma("unroll") for (int k = 0; k < 2; ++k) \
        acc[ai][bj][m][n] = __builtin_amdgcn_mfma_f32_16x16x32_bf16(Bt[n][k], At[m][k], acc[ai][bj][m][n], 0, 0, 0); __builtin_amdgcn_s_setprio(0); } while (0)
#define PG8_WAIT_V(n) asm volatile("s_waitcnt vmcnt(" #n ")" ::: "memory")
#define PG8_WAIT_L(n) asm volatile("s_waitcnt lgkmcnt(" #n ")" ::: "memory")
#define PG8_BAR __builtin_amdgcn_s_barrier()
#define PG8_SCHED __builtin_amdgcn_sched_barrier(0)
    Unit cur, nxt; int ui = 0;
    if (!S.next(0, cur)) return;
    f32x4 acc[2][2][4][2];
#pragma unroll
    for (int a = 0; a < 2; ++a)
#pragma unroll
        for (int b = 0; b < 2; ++b)
#pragma unroll
            for (int m = 0; m < 4; ++m)
#pragma unroll
                for (int n = 0; n < 2; ++n) acc[a][b][m][n] = (f32x4){0.f, 0.f, 0.f, 0.f};
    bf16x8 At[4][2], B0[2][2], B1[2][2];
    unsigned va[4], vn[4];
    S.a_off(cur, tid, K, va);
    const char* cA = S.a_base(cur); const char* cB = S.b_base(cur);
    PG8_STAGE(PG8_SB(0, 0), cB, voffB); PG8_STAGE(PG8_SB(0, 1), cB + hB, voffB); PG8_STAGE(PG8_SA(0, 0), cA, va); PG8_STAGE(PG8_SA(0, 1), cA, va + 2);
    if (wr == 1) PG8_BAR;
    PG8_WAIT_V(2); PG8_BAR;
    PG8_STAGE(PG8_SB(1, 0), cB + kstep, voffB); PG8_STAGE(PG8_SA(1, 0), cA + kstep, va); PG8_STAGE(PG8_SB(1, 1), cB + hB + kstep, voffB);
    PG8_WAIT_V(6); PG8_BAR;
    for (;;) {
        const bool has_next = S.next(ui + 1, nxt);
        const char* nA = has_next ? S.a_base(nxt) : cA; const char* nB = has_next ? S.b_base(nxt) : cB;
        if constexpr (Sched::EARLY_OFF) { if (has_next) S.a_pre(nxt, tid, vn); }
#pragma nounroll
        for (int t = 0; t < nt; t += 2) {
            const bool last = (t == nt - 2);
            const char* a1 = cA + (size_t)(t + 1) * kstep;
            const char* a2 = last ? nA : cA + (size_t)(t + 2) * kstep; const char* b2 = last ? nB : cB + (size_t)(t + 2) * kstep;
            const char* a3 = a2 + kstep; const char* b3 = b2 + kstep;
            PG8_LDB(B0, 0, 0); PG8_LDB(B1, 0, 1); PG8_SCHED; PG8_LDA(At, 0, 0); PG8_STAGE(PG8_SA(1, 1), a1, va + 2);
            PG8_WAIT_V(8); PG8_WAIT_L(0); PG8_BAR; PG8_MMA(0, 0, At, B0); PG8_MMA(0, 1, At, B1); PG8_BAR; PG8_SCHED;
            if (last) {
                if (has_next) { if constexpr (Sched::EARLY_OFF) S.a_fin(nxt, tid, K, vn, va); else S.a_off(nxt, tid, K, va); } }
            PG8_LDA(At, 0, 1); PG8_STAGE(PG8_SB(0, 0), b2, voffB); PG8_STAGE(PG8_SB(0, 1), b2 + hB, voffB); PG8_STAGE(PG8_SA(0, 0), a2, va);
            PG8_WAIT_V(8); PG8_WAIT_L(0); PG8_BAR; PG8_MMA(1, 0, At, B0); PG8_MMA(1, 1, At, B1); PG8_BAR; PG8_SCHED;
            PG8_LDB(B0, 1, 0); PG8_LDB(B1, 1, 1); PG8_SCHED; PG8_LDA(At, 1, 0); PG8_STAGE(PG8_SA(0, 1), a2, va + 2);
            PG8_WAIT_V(8); PG8_WAIT_L(0); PG8_BAR; PG8_MMA(0, 0, At, B0); PG8_MMA(0, 1, At, B1); PG8_BAR; PG8_SCHED;
            PG8_LDA(At, 1, 1); PG8_STAGE(PG8_SB(1, 0), b3, voffB); PG8_STAGE(PG8_SB(1, 1), b3 + hB, voffB); PG8_STAGE(PG8_SA(1, 0), a3, va);
            PG8_WAIT_V(8); PG8_WAIT_L(0); PG8_BAR; PG8_MMA(1, 0, At, B0); PG8_MMA(1, 1, At, B1); PG8_BAR; PG8_SCHED;
        }
        if constexpr (ALIGN_EPI) { if (wr == 0) PG8_BAR; }
        E(acc, cur, wr, wc, fr, fq);
        if (!has_next) break;
#pragma unroll
        for (int a = 0; a < 2; ++a)
#pragma unroll
            for (int b = 0; b < 2; ++b)
#pragma unroll
                for (int m = 0; m < 4; ++m)
#pragma unroll
                    for (int n = 0; n < 2; ++n) acc[a][b][m][n] = (f32x4){0.f, 0.f, 0.f, 0.f};
        cur = nxt; cA = nA; cB = nB; ++ui;
        if constexpr (ALIGN_EPI) { if (wr == 1) PG8_BAR; }
    }
    PG8_WAIT_V(0);
    if constexpr (!ALIGN_EPI) { if (wr == 0) PG8_BAR; }
    PG8_BAR;
#undef PG8_SA
#undef PG8_SB
#undef PG8_STAGE
#undef PG8_LDA
#undef PG8_LDB
#undef PG8_MMA
#undef PG8_WAIT_V
#undef PG8_WAIT_L
#undef PG8_BAR
#undef PG8_SCHED
}

__device__ __forceinline__ int xcd_deal(int i, int G, int c, int total) {
    const int per = (total + 7) >> 3, x = c & 7, j = i * (G >> 3) + (c >> 3);
    if (j >= per) return -1; const int u = x * per + j; return u < total ? u : -1;
}

struct DenseSched {
    static constexpr bool EARLY_OFF = false;
    const char* A; const char* Bt; int nM, nN, nwg, G, c, K;
    __device__ __forceinline__ void init(const void* A_, const void* Bt_, int M, int N, int K_, int G_, int c_) { A = (const char*)A_; Bt = (const char*)Bt_; nM = M / BM; nN = N / BM; nwg = nM * nN; G = G_; c = c_; K = K_; }
    __device__ __forceinline__ bool next(int i, Unit& u) const {
        const long L = (long)i * G + c; if (L >= nwg) return false;
        int wgid = (int)L; { const int q = nwg / NXCD, r = nwg % NXCD, xcd = wgid % NXCD, off = wgid / NXCD; wgid = (xcd < r ? xcd * (q + 1) : r * (q + 1) + (xcd - r) * q) + off; }
        const int nig = WGM * nN, gid = wgid / nig, fm = gid * WGM, gsz = (nM - fm) < WGM ? (nM - fm) : WGM;
        u.pm = fm + ((wgid % nig) % gsz); u.pn = (wgid % nig) / gsz; u.e = 0; u.base = u.pm * BM; u.cnt = BM; return true;
    }
    __device__ __forceinline__ const char* a_base(const Unit&) const { return A; }
    __device__ __forceinline__ void a_off(const Unit& u, int tid, int K_, unsigned (&vo)[4]) const {
        asm volatile("" : "+v"(tid)); int Ra[2], Ca[2]; stage_rc(tid * 16, Ra[0], Ca[0]); stage_rc(tid * 16 + 8192, Ra[1], Ca[1]);
#pragma unroll
        for (int h = 0; h < 2; ++h)
#pragma unroll
            for (int i = 0; i < 2; ++i) vo[h * 2 + i] = (unsigned)((u.pm * BM + h * HALF + Ra[i]) * K_ + Ca[i]) * 2u;
    }
    __device__ __forceinline__ const char* b_base(const Unit& u) const { return Bt + (size_t)u.pn * BM * K * 2; }
    __device__ __forceinline__ size_t b_hstep(int K_) const { return (size_t)HALF * K_ * 2; }
};
}

struct ProjSched {
    static constexpr bool EARLY_OFF = false;
    const char *XBp, *WINp, *MEMBp, *WKVp; int G, c;
    __device__ __forceinline__ bool next(int i, pg8::Unit& u) const {
        const int L = i * G + c; if (L >= 416) return false;
        int pm, pn, e;
        if (L < 384) { const int wgid = (L & 7) * 48 + (L >> 3);
            pm = (wgid / 48) * 8 + (wgid % 48) % 8; pn = (wgid % 48) / 8; e = 0; }
        else { const int q = L - 384; pm = q >> 3; pn = q & 7; e = 1; }
        u.pm = pm; u.pn = pn; u.e = e; u.base = pm * 256; u.cnt = 256;
        return true;
    }
    __device__ __forceinline__ const char* a_base(const pg8::Unit& u) const { return u.e ? MEMBp : XBp; }
    __device__ __forceinline__ void a_off(const pg8::Unit& u, int tid, int K_, unsigned (&vo)[4]) const {
        asm volatile("" : "+v"(tid)); int Ra[2], Ca[2]; pg8::stage_rc(tid * 16, Ra[0], Ca[0]); pg8::stage_rc(tid * 16 + 8192, Ra[1], Ca[1]);
#pragma unroll
        for (int h = 0; h < 2; ++h)
#pragma unroll
            for (int i = 0; i < 2; ++i) vo[h * 2 + i] = (unsigned)((u.pm * 256 + h * 128 + Ra[i]) * K_ + Ca[i]) * 2u;
    }
    __device__ __forceinline__ const char* b_base(const pg8::Unit& u) const { return (u.e ? WKVp : WINp) + (size_t)u.pn * 256 * 1024 * 2; }
    __device__ __forceinline__ size_t b_hstep(int K_) const { return (size_t)128 * K_ * 2; }
};
struct EpiProj {
    static constexpr bool PERM = true;
    bf16 *CV, *AS, *KB, *VT;
    __device__ __forceinline__ void operator()(const f32x4 (&acc)[2][2][4][2], const pg8::Unit& u, int wr, int wc, int fr, int fq) const {
        int r0 = wr * 64 + fr; asm volatile("" : "+v"(r0));
#pragma unroll
        for (int ai = 0; ai < 2; ++ai)
#pragma unroll
            for (int m = 0; m < 4; ++m) { const int row = u.pm * 256 + ai * 128 + m * 16 + r0;
#pragma unroll
                for (int bj = 0; bj < 2; ++bj) { const int col = u.pn * 256 + bj * 128 + wc * 32 + 8 * fq; const f32x4 v0 = acc[ai][bj][m][0], v1 = acc[ai][bj][m][1];
                    v4u w; w.x = pg8::cvt_pk_bf16(v0[0], v0[1]); w.y = pg8::cvt_pk_bf16(v0[2], v0[3]); w.z = pg8::cvt_pk_bf16(v1[0], v1[1]); w.w = pg8::cvt_pk_bf16(v1[2], v1[3]);
                    if (u.e == 0) { if (u.pn < 4) *(v4u*)(CV + (size_t)row * 1024 + col) = w;
                        else { const int ch = col - 1024, g = ch >> 4, h = ch & 15; *(v4u*)(AS + ((size_t)(g * NCH + (row >> 4)) * 384 + (row & 15) * 16 + h)) = w; } }
                    else { if (u.pn < 4) *(v4u*)(KB + (size_t)row * 1024 + col) = w;
                        else { const int d = col - 1024, b = row >> 8, key = row & 255; bf16* vp = VT + ((size_t)(b * 1024 + d)) * 256 + key;
                            vp[0 * 256] = (bf16)(w.x & 0xffffu); vp[1 * 256] = (bf16)(w.x >> 16); vp[2 * 256] = (bf16)(w.y & 0xffffu); vp[3 * 256] = (bf16)(w.y >> 16);
                            vp[4 * 256] = (bf16)(w.z & 0xffffu); vp[5 * 256] = (bf16)(w.z >> 16); vp[6 * 256] = (bf16)(w.w & 0xffffu); vp[7 * 256] = (bf16)(w.w >> 16); } } } }
    }
};
struct EpiResF32 {
    static constexpr bool PERM = false;
    const float* res; float* out;
    __device__ __forceinline__ void operator()(const f32x4 (&acc)[2][2][4][2], const pg8::Unit& u, int wr, int wc, int fr, int fq) const {
        int r0 = wr * 64 + fr; asm volatile("" : "+v"(r0));
#pragma unroll
        for (int ai = 0; ai < 2; ++ai)
#pragma unroll
            for (int m = 0; m < 4; ++m) { const size_t ro = (size_t)(u.pm * 256 + ai * 128 + m * 16 + r0) * D + u.pn * 256 + wc * 32 + 4 * fq;
#pragma unroll
                for (int bj = 0; bj < 2; ++bj)
#pragma unroll
                    for (int n = 0; n < 2; ++n) { const size_t o = ro + bj * 128 + n * 16; const f32x4 r = *(const f32x4*)(res + o); *(f32x4*)(out + o) = r * ALPHA + acc[ai][bj][m][n]; } }
    }
};
struct EpiBf16S {
    static constexpr bool PERM = true;
    bf16* out; float scale;
    __device__ __forceinline__ void operator()(const f32x4 (&acc)[2][2][4][2], const pg8::Unit& u, int wr, int wc, int fr, int fq) const {
        int r0 = wr * 64 + fr; asm volatile("" : "+v"(r0));
#pragma unroll
        for (int ai = 0; ai < 2; ++ai)
#pragma unroll
            for (int m = 0; m < 4; ++m) { const size_t ro = (size_t)(u.pm * 256 + ai * 128 + m * 16 + r0) * D + u.pn * 256 + wc * 32 + 8 * fq;
#pragma unroll
                for (int bj = 0; bj < 2; ++bj) { const f32x4 v0 = acc[ai][bj][m][0] * scale, v1 = acc[ai][bj][m][1] * scale;
                    v4u w; w.x = pg8::cvt_pk_bf16(v0[0], v0[1]); w.y = pg8::cvt_pk_bf16(v0[2], v0[3]); w.z = pg8::cvt_pk_bf16(v1[0], v1[1]); w.w = pg8::cvt_pk_bf16(v1[2], v1[3]);
                    *(v4u*)(out + ro + bj * 128) = w; } }
    }
};
template <bool GATEUP>
struct MoeSched {
    static constexpr int NPN = GATEUP ? 2 : 4; static constexpr bool EARLY_OFF = GATEUP;
    const bf16 *X, *XS, *W, *WS; const int* stok; const LAS int* off; const LAS int* tst; int nmoe, total, G, c; LAS unsigned char* tokl;
    __device__ __forceinline__ bool next(int i, pg8::Unit& u) const {
        const int idx = pg8::xcd_deal(i, G, c, total); if (idx < 0) return false;
        const int mtg = idx / NPN; u.pn = idx % NPN;
        if (mtg >= nmoe) { u.e = 256; u.pm = mtg - nmoe; u.base = (GATEUP ? NASSIGN : 0) + u.pm * 256; u.cnt = 256; }
        else { int lo_ = 0, hi_ = 256; while (hi_ - lo_ > 1) { const int mid = (lo_ + hi_) >> 1; if (tst[mid] <= mtg) lo_ = mid; else hi_ = mid; }
            u.e = lo_; u.pm = mtg - tst[lo_]; u.base = off[lo_] + u.pm * 256; u.cnt = off[lo_ + 1] - u.base; }
        u.e = __builtin_amdgcn_readfirstlane(u.e); u.pm = __builtin_amdgcn_readfirstlane(u.pm); u.pn = __builtin_amdgcn_readfirstlane(u.pn);
        u.base = __builtin_amdgcn_readfirstlane(u.base); u.cnt = __builtin_amdgcn_readfirstlane(u.cnt);
        return true;
    }
    __device__ __forceinline__ const char* a_base(const pg8::Unit& u) const { return (const char*)((!GATEUP && u.e == 256) ? XS : X); }
    __device__ __forceinline__ void a_pre(const pg8::Unit& u, int tid, unsigned (&vr)[4]) const {
        asm volatile("" : "+v"(tid)); int Ra[2], Ca[2]; pg8::stage_rc(tid * 16, Ra[0], Ca[0]); pg8::stage_rc(tid * 16 + 8192, Ra[1], Ca[1]);
        if constexpr (GATEUP) { const int* sp = stok + u.base; const int cm = u.cnt - 1;
            const int wv = __builtin_amdgcn_readfirstlane(tid >> 6);
#pragma unroll
            for (int h = 0; h < 2; ++h)
#pragma unroll
                for (int i = 0; i < 2; ++i) { const int r = h * 128 + Ra[i];
                    __builtin_amdgcn_global_load_lds((const unsigned*)(sp + (r < cm ? r : cm)), (LAS unsigned*)(tokl + wv * 1024 + (h * 2 + i) * 256), 4, 0, 0); vr[h * 2 + i] = 0u; } }
        else {
#pragma unroll
            for (int h = 0; h < 2; ++h)
#pragma unroll
                for (int i = 0; i < 2; ++i) vr[h * 2 + i] = (unsigned)(u.base + h * 128 + Ra[i]); }
    }
    __device__ __forceinline__ void a_fin(const pg8::Unit& u, int tid, int K_, const unsigned (&vr)[4], unsigned (&vo)[4]) const {
        asm volatile("" : "+v"(tid)); int Ra[2], Ca[2]; pg8::stage_rc(tid * 16, Ra[0], Ca[0]); pg8::stage_rc(tid * 16 + 8192, Ra[1], Ca[1]);
#pragma unroll
        for (int h = 0; h < 2; ++h)
#pragma unroll
            for (int i = 0; i < 2; ++i) { unsigned rv;
                if constexpr (GATEUP) rv = *(const LAS unsigned*)(tokl + (tid >> 6) * 1024 + (h * 2 + i) * 256 + (tid & 63) * 4); else rv = vr[h * 2 + i];
                vo[h * 2 + i] = (rv * (unsigned)K_ + (unsigned)Ca[i]) * 2u; }
    }
    __device__ __forceinline__ void a_off(const pg8::Unit& u, int tid, int K_, unsigned (&vo)[4]) const { unsigned vr[4]; a_pre(u, tid, vr); if constexpr (GATEUP) asm volatile("s_waitcnt vmcnt(0)" ::: "memory"); a_fin(u, tid, K_, vr, vo); }
    __device__ __forceinline__ const char* b_base(const pg8::Unit& u) const {
        if (GATEUP) return (const char*)((u.e == 256 ? WS : W + (size_t)u.e * 512 * 1024) + (size_t)u.pn * 128 * 1024);
        else return (const char*)((u.e == 256 ? WS : W + (size_t)u.e * 1024 * 256) + (size_t)u.pn * 256 * 256);
    }
    __device__ __forceinline__ size_t b_hstep(int K_) const { return GATEUP ? (size_t)256 * K_ * 2 : (size_t)128 * K_ * 2; }
};
struct EpiGateUp {
    static constexpr bool PERM = true;
    bf16 *H, *HS;
    __device__ __forceinline__ void operator()(const f32x4 (&acc)[2][2][4][2], const pg8::Unit& u, int wr, int wc, int fr, int fq) const {
        int r0 = wr * 64 + fr; asm volatile("" : "+v"(r0));
        bf16* bp = H + (size_t)u.base * DE + u.pn * 128 + wc * 32 + 8 * fq;
#pragma unroll
        for (int ai = 0; ai < 2; ++ai)
#pragma unroll
            for (int m = 0; m < 4; ++m) { const int r = ai * 128 + m * 16 + r0;
                if (r < u.cnt) { float hv[8];
#pragma unroll
                    for (int n = 0; n < 2; ++n)
#pragma unroll
                        for (int j = 0; j < 4; ++j) { const float g = acc[ai][0][m][n][j], up = acc[ai][1][m][n][j]; hv[n * 4 + j] = g * sigmoidf_(g) * up; }
                    v4u w; w.x = pg8::cvt_pk_bf16(hv[0], hv[1]); w.y = pg8::cvt_pk_bf16(hv[2], hv[3]); w.z = pg8::cvt_pk_bf16(hv[4], hv[5]); w.w = pg8::cvt_pk_bf16(hv[6], hv[7]);
                    *(v4u*)(bp + (size_t)r * DE) = w; } }
    }
};
struct EpiDown {
    static constexpr bool PERM = true;
    bf16 *Y, *YS; const float* sgate;
    __device__ __forceinline__ void operator()(const f32x4 (&acc)[2][2][4][2], const pg8::Unit& u, int wr, int wc, int fr, int fq) const {
        int r0 = wr * 64 + fr; asm volatile("" : "+v"(r0));
        bf16* bp = (u.e == 256 ? YS : Y) + (size_t)u.base * D + u.pn * 256 + wc * 32 + 8 * fq;
#pragma unroll
        for (int ai = 0; ai < 2; ++ai)
#pragma unroll
            for (int m = 0; m < 4; ++m) { const int r = ai * 128 + m * 16 + r0;
                if (r < u.cnt) { const float gt = (u.e == 256) ? 1.0f : sgate[u.base + r];
#pragma unroll
                    for (int bj = 0; bj < 2; ++bj) { const f32x4 v0 = acc[ai][bj][m][0] * gt, v1 = acc[ai][bj][m][1] * gt;
                        v4u w; w.x = pg8::cvt_pk_bf16(v0[0], v0[1]); w.y = pg8::cvt_pk_bf16(v0[2], v0[3]); w.z = pg8::cvt_pk_bf16(v1[0], v1[1]); w.w = pg8::cvt_pk_bf16(v1[2], v1[3]);
                        *(v4u*)(bp + (size_t)r * D + bj * 128) = w; } } }
    }
};

__device__ __forceinline__ void p0_transpose_item(const float* W, int K, int N, bf16* WT, int row_off, LAS unsigned char* scr, int item, int lane) {
    const int nblk = N / 64, kb = item / nblk, nb = item % nblk, k0 = 64 * kb, n0 = 64 * nb;
    const float* src = W + (size_t)k0 * N + n0 + lane;
    float v[64];
#pragma unroll
    for (int j = 0; j < 64; ++j) v[j] = __builtin_nontemporal_load(src + (size_t)j * N);
#pragma unroll
    for (int g = 0; g < 8; ++g) { v4u o; o.x = pk2(v[8 * g], v[8 * g + 1]); o.y = pk2(v[8 * g + 2], v[8 * g + 3]); o.z = pk2(v[8 * g + 4], v[8 * g + 5]); o.w = pk2(v[8 * g + 6], v[8 * g + 7]);
        *(LAS v4u*)(scr + lane * 144 + g * 16) = o; }
    LDS_WAIT(); asm volatile("" ::: "memory");
    bf16* dst = WT + (size_t)(row_off + n0 + (lane >> 3)) * K + k0 + (lane & 7) * 8;
#pragma unroll
    for (int j = 0; j < 8; ++j) { const v4u o = *(const LAS v4u*)(scr + (8 * j + (lane >> 3)) * 144 + (lane & 7) * 16); *(v4u*)(dst + (size_t)(8 * j) * K) = o; }
    LDS_WAIT(); asm volatile("" ::: "memory");
}

__device__ __forceinline__ void sincos_d(double x, float& s, float& c) {
    const double k = __builtin_rint(x * 0.63661977236758134308);
    double r = __builtin_fma(-k, 1.57079632679489655800e+00, x); r = __builtin_fma(-k, 6.12323399573676603587e-17, r);
    const int q = ((int)k) & 3;
    const float rf = (float)r, z = rf * rf;
    const float sp = rf + rf * z * (-1.6666667163e-01f + z * (8.3333337680e-03f + z * (-1.9841270114e-04f + z * 2.7557314297e-06f)));
    const float cp = 1.0f - 0.5f * z + z * z * (4.1666667908e-02f + z * (-1.3888889225e-03f + z * (2.4801587642e-05f + z * -2.7557314297e-07f)));
    s = (q == 0) ? sp : (q == 1) ? cp : (q == 2) ? -sp : -cp;
    c = (q == 0) ? cp : (q == 1) ? -sp : (q == 2) ? -cp : sp;
}

__device__ __forceinline__ void p0_ssm_group(int g, int tid, LAS unsigned char* lds, const float* log_dt, const float* a_re, const float* a_im,
                                             const float* b_re, const float* b_im, const float* c_re, const float* c_im, bf16* W1, bf16* W2, float* LAM16) {
    LAS float* lp_re = (LAS float*)lds;
    LAS float* lp_im = lp_re + 17 * 64;
    LAS float* bb_re = lp_im + 17 * 64;
    LAS float* bb_im = bb_re + 1024;
    LAS float* cc_re = bb_im + 1024;
    LAS float* cc_im = cc_re + 1024;
    LAS float* ktab = cc_im + 1024;
    __syncthreads();
    const float dt = __expf(log_dt[g]);
    if (tid < 64) {
        const int p = tid; const float a = a_re[g * 64 + p], w = a_im[g * 64 + p];
        for (int tau = 0; tau <= 16; ++tau) { float s, c; sincos_d((double)w * (double)dt * (double)tau, s, c); const float mg = __expf(a * dt * (float)tau);
            lp_re[tau * 64 + p] = mg * c; lp_im[tau * 64 + p] = mg * s; }
        const float lr = lp_re[64 + p], li = lp_im[64 + p];
        const float den = a * a + w * w;
        const float cr = ((lr - 1.0f) * a + li * w) / den, ci = (li * a - (lr - 1.0f) * w) / den;
        for (int h = 0; h < 16; ++h) { const float br = b_re[(g * 64 + p) * 16 + h], bi = b_im[(g * 64 + p) * 16 + h];
            bb_re[p * 16 + h] = cr * br - ci * bi; bb_im[p * 16 + h] = cr * bi + ci * br; }
        LAM16[(g * 64 + p) * 2 + 0] = lp_re[16 * 64 + p]; LAM16[(g * 64 + p) * 2 + 1] = lp_im[16 * 64 + p];
    }
    for (int i = tid; i < 1024; i += NTHR) { cc_re[i] = c_re[g * 1024 + i]; cc_im[i] = c_im[g * 1024 + i]; }
    __syncthreads();
    for (int e = tid; e < 4096; e += NTHR) { const int tau = e >> 8, h = (e >> 4) & 15, hp = e & 15; float acc = 0.f;
        for (int p = 0; p < 64; ++p) { const float lr = lp_re[tau * 64 + p], li = lp_im[tau * 64 + p], br = bb_re[p * 16 + hp], bi = bb_im[p * 16 + hp];
            const float zr = lr * br - li * bi, zi = lr * bi + li * br;
            acc += cc_re[h * 64 + p] * zr - cc_im[h * 64 + p] * zi; }
        ktab[e] = acc; }
    __syncthreads();
    bf16* w1 = W1 + (size_t)g * 128 * 256;
    for (int e = tid; e < 128 * 256; e += NTHR) { const int n = e >> 8, k = e & 255, p = n & 63, j = k >> 4, hp = k & 15, tau = 15 - j;
        const float lr = lp_re[tau * 64 + p], li = lp_im[tau * 64 + p], br = bb_re[p * 16 + hp], bi = bb_im[p * 16 + hp];
        const float v = (n < 64) ? (lr * br - li * bi) : (lr * bi + li * br);
        w1[e] = (bf16)f2bf(v); }
    bf16* w2 = W2 + (size_t)g * 256 * 384;
    for (int e = tid; e < 256 * 384; e += NTHR) { const int n = e / 384, k = e % 384, i = n >> 4, h = n & 15; float v;
        if (k < 256) { const int j = k >> 4, hp = k & 15; v = (j <= i) ? ktab[((i - j) << 8) + (h << 4) + hp] : 0.f; }
        else { const int q = k - 256, p = q & 63, tau = i + 1; const float lr = lp_re[tau * 64 + p], li = lp_im[tau * 64 + p], cr = cc_re[h * 64 + p], ci = cc_im[h * 64 + p];
            v = (q < 64) ? (cr * lr - ci * li) : -(cr * li + ci * lr); }
        w2[e] = (bf16)f2bf(v); }
    __syncthreads();
}

struct Args { const float* in[38]; float* out; unsigned char* ws; int ph_lo, ph_hi; };

constexpr int N_PHASES = 19;

__global__ void __launch_bounds__(NTHR, 2) fwd(Args args) {
    extern __shared__ __attribute__((aligned(16))) unsigned char lds_raw[];
    LAS unsigned char* lds = (LAS unsigned char*)lds_raw;
    volatile LAS unsigned* MISC = (volatile LAS unsigned*)(lds + MISC_OFF);
    const int tid = threadIdx.x, lane = tid & 63, wave = __builtin_amdgcn_readfirstlane(tid >> 6);
    const int G = gridDim.x; const int bx = blockIdx.x; const int vcu = (G % 8 == 0) ? (bx % 8) * (G / 8) + bx / 8 : bx;
    const int gw = vcu * NWAVES + wave, ngw = G * NWAVES;
    const int gtid = vcu * NTHR + tid, ngt = G * NTHR;
    const int fr = lane & 15, fq = lane >> 4;
    unsigned char* ws = args.ws;
    unsigned* ctl = (unsigned*)(ws + WS_CTL);
    for (int u = tid; u < (LDS_BYTES - 131072) / 4; u += NTHR) ((LAS unsigned*)(lds + 131072))[u] = 0u;
    __syncthreads();
#if MK_SPLIT
#define GRID_BAR() do { } while (0)
#else
    XcdBarrier bar = xcd_barrier_post(ctl + CW_BAR, MISC + 8);
#define GRID_BAR() xcd_barrier(bar)
#endif
    const int lo = args.ph_lo, hi = args.ph_hi;
#ifndef PROBE_DUP_P0
#define PROBE_DUP_P0 0
#endif
#ifndef ONLY_PHASE
#define ONLY_PHASE -1
#endif
#define IN(k) ((ONLY_PHASE < 0 || ONLY_PHASE == (k)) && lo <= (k) && (k) < hi)
#define BOTH(k) (IN(k) && IN((k) + 1))

    const float* x = args.in[0];
    bf16* XB = (bf16*)(ws + WS_XB); bf16* CV = (bf16*)(ws + WS_CV); bf16* AS = (bf16*)(ws + WS_AS); float* SEND = (float*)(ws + WS_SEND);
    bf16* Z = (bf16*)(ws + WS_Z); float* ZG = (float*)(ws + WS_ZG); bf16* MERGED = (bf16*)(ws + WS_MERGED); float* Y1 = (float*)(ws + WS_Y1);
    float* X1 = (float*)(ws + WS_X1); bf16* X1B = (bf16*)(ws + WS_X1B); bf16* Q = (bf16*)(ws + WS_Q); bf16* O = (bf16*)(ws + WS_O);
    float* X2 = (float*)(ws + WS_X2); bf16* X2B = (bf16*)(ws + WS_X2B); float* LOGITS = (float*)(ws + WS_LOGITS);
    bf16* H = (bf16*)(ws + WS_H); bf16* HS = (bf16*)(ws + WS_HS); bf16* Y = (bf16*)(ws + WS_Y); bf16* YS = (bf16*)(ws + WS_YS);
    bf16* W_IN_T = (bf16*)(ws + WS_W_IN_T); bf16* W_GLU_T = (bf16*)(ws + WS_W_GLU_T); bf16* W_OUT_T = (bf16*)(ws + WS_W_OUT_T);
    bf16* WQ_T = (bf16*)(ws + WS_WQ_T); bf16* WKV_T = (bf16*)(ws + WS_WKV_T); bf16* WO_T = (bf16*)(ws + WS_WO_T); bf16* WR_T = (bf16*)(ws + WS_WR_T);
    bf16* SSM_W1 = (bf16*)(ws + WS_SSM_W1); bf16* SSM_W2 = (bf16*)(ws + WS_SSM_W2); float* LAM16 = (float*)(ws + WS_LAM16);
    bf16* SH_GU_T = (bf16*)(ws + WS_SH_GU_T); bf16* SH_D_T = (bf16*)(ws + WS_SH_D_T);
    bf16* MEMB = (bf16*)(ws + WS_MEMB); bf16* KB = (bf16*)(ws + WS_KB); bf16* VT = (bf16*)(ws + WS_VT);
    bf16* WGU_T = (bf16*)(ws + WS_WGU_T); bf16* WD_T = (bf16*)(ws + WS_WD_T);
    int* TOPE = (int*)(ws + WS_TOPE); int* TOPP = (int*)(ws + WS_TOPP); float* GATE = (float*)(ws + WS_GATE); int* SLOT = (int*)(ws + WS_SLOT);
    int* STOK = (int*)(ws + WS_STOK); float* SGATE = (float*)(ws + WS_SGATE);
    unsigned* CNT = ctl + CW_CNT;

    if (IN(0)) {
        LAS unsigned char* scr = lds + wave * 9216;
        constexpr int I_SMALL = 384 + 64 + 256 * 4 + 256 + 64 * 4;
        for (int rep = 0; rep <= PROBE_DUP_P0; ++rep)
        for (int mi = vcu; mi < NE * 3; mi += G) { const int e = mi / 3, w3 = mi % 3;
            for (int q = wave; q < 64; q += NWAVES) {
                if (w3 == 0) p0_transpose_item(args.in[30] + (size_t)e * D * DE, D, DE, WGU_T + (size_t)e * 512 * D, 0, scr, q, lane);
                else if (w3 == 1) p0_transpose_item(args.in[31] + (size_t)e * D * DE, D, DE, WGU_T + (size_t)e * 512 * D, 256, scr, q, lane);
                else p0_transpose_item(args.in[32] + (size_t)e * DE * D, DE, D, WD_T + (size_t)e * D * DE, 0, scr, q, lane); } }
        for (int it = gw; it < I_SMALL; it += ngw) {
            int r = it;
            if (r < 384) { p0_transpose_item(args.in[2], D, 1536, W_IN_T, 0, scr, r, lane); continue; } r -= 384;
            if (r < 64) { p0_transpose_item(args.in[15], 512, 512, W_GLU_T, 0, scr, r, lane); continue; } r -= 64;
            if (r < 256) { p0_transpose_item(args.in[19], D, D, W_OUT_T, 0, scr, r, lane); continue; } r -= 256;
            if (r < 256) { p0_transpose_item(args.in[22], D, D, WQ_T, 0, scr, r, lane); continue; } r -= 256;
            if (r < 256) { p0_transpose_item(args.in[23], D, D, WKV_T, 0, scr, r, lane); continue; } r -= 256;
            if (r < 256) { p0_transpose_item(args.in[24], D, D, WKV_T, 1024, scr, r, lane); continue; } r -= 256;
            if (r < 256) { p0_transpose_item(args.in[25], D, D, WO_T, 0, scr, r, lane); continue; } r -= 256;
            if (r < 64) { p0_transpose_item(args.in[28], D, 256, WR_T, 0, scr, r, lane); continue; } r -= 64;
            if (r < 64) { p0_transpose_item(args.in[33], D, 256, SH_GU_T, 0, scr, r, lane); continue; } r -= 64;
            if (r < 64) { p0_transpose_item(args.in[34], D, 256, SH_GU_T, 256, scr, r, lane); continue; } r -= 64;
            p0_transpose_item(args.in[35], 256, D, SH_D_T, 0, scr, r, lane);
        }
        for (size_t i = (size_t)gtid * 8; i < (size_t)T * D; i += (size_t)ngt * 8) { const f32x4 a = *(const f32x4*)(x + i), b = *(const f32x4*)(x + i + 4);
            v4u o; o.x = pk2(a[0], a[1]); o.y = pk2(a[2], a[3]); o.z = pk2(b[0], b[1]); o.w = pk2(b[2], b[3]); *(v4u*)(XB + i) = o; }
        for (size_t i = (size_t)gtid * 8; i < (size_t)NB * MEML * D; i += (size_t)ngt * 8) { const f32x4 a = *(const f32x4*)(args.in[1] + i), b = *(const f32x4*)(args.in[1] + i + 4);
            v4u o; o.x = pk2(a[0], a[1]); o.y = pk2(a[2], a[3]); o.z = pk2(b[0], b[1]); o.w = pk2(b[2], b[3]); *(v4u*)(MEMB + i) = o; }
        __syncthreads();
        for (int g = vcu; g < NG; g += G)
            p0_ssm_group(g, tid, lds, args.in[7], args.in[8], args.in[9], args.in[10], args.in[11], args.in[12], args.in[13], SSM_W1, SSM_W2, LAM16);
        if (BOTH(0)) GRID_BAR();
    }

    if (IN(1)) {
        ProjSched S{(const char*)XB, (const char*)W_IN_T, (const char*)MEMB, (const char*)WKV_T, G, bx};
        EpiProj E{CV, AS, KB, VT};
        pg8::gemm_phase<EpiProj, ProjSched, true>(lds, D, S, E);
        if (BOTH(1)) GRID_BAR();
    }

    if (IN(2)) {
        constexpr int TPG = (NCH / 64) * 2, TILES = NG * TPG;
        for (int t = gw; t < TILES; t += ngw) {
            const int g = t / TPG, q = t % TPG, m0 = (q >> 1) * 64, n0 = (q & 1) * 64;
            const bf16* ar[4]; const bf16* br[4];
#pragma unroll
            for (int i = 0; i < 4; ++i) { ar[i] = AS + ((size_t)(g * NCH + m0 + 16 * i + fr)) * 384 + fq * 8; br[i] = SSM_W1 + ((size_t)(g * 128 + n0 + 16 * i + fr)) * 256 + fq * 8; }
            f32x4 acc[4][4]; zero_acc(acc);
            wave_mma<4, 4>(ar, br, 256, acc);
#pragma unroll
            for (int i = 0; i < 4; ++i)
#pragma unroll
                for (int j = 0; j < 4; ++j) *(f32x4*)(SEND + ((size_t)(g * NCH + m0 + 16 * i + fr)) * 128 + n0 + 16 * j + 4 * fq) = acc[i][j];
        }
        if (BOTH(2)) GRID_BAR();
    }

    if (IN(3)) {
        constexpr int NSCAN = 16;
        if (vcu < NSCAN && G > NSCAN) {
            const int g = gw >> 2, b = gw & 3, p = lane;
            const float lr = LAM16[(g * 64 + p) * 2], li = LAM16[(g * 64 + p) * 2 + 1];
            float sr = 0.f, si = 0.f;
            const float* sp = SEND + ((size_t)(g * NCH + b * 256)) * 128 + p; bf16* ap = AS + ((size_t)(g * NCH + b * 256)) * 384 + 256 + p;
            float er[16], ei[16], nr_[16], ni_[16];
#pragma unroll
            for (int q = 0; q < 16; ++q) { er[q] = sp[(size_t)q * 128]; ei[q] = sp[(size_t)q * 128 + 64]; }
            for (int c0 = 0; c0 < SEQ / LC; c0 += 16) {
                const int cn = (c0 + 16 < SEQ / LC) ? c0 + 16 : c0;
#pragma unroll
                for (int q = 0; q < 16; ++q) { nr_[q] = sp[(size_t)(cn + q) * 128]; ni_[q] = sp[(size_t)(cn + q) * 128 + 64]; }
#pragma unroll
                for (int q = 0; q < 16; ++q) { ap[(size_t)(c0 + q) * 384] = (bf16)f2bf(sr); ap[(size_t)(c0 + q) * 384 + 64] = (bf16)f2bf(si);
                    const float nr = lr * sr - li * si + er[q], ni = lr * si + li * sr + ei[q]; sr = nr; si = ni; }
#pragma unroll
                for (int q = 0; q < 16; ++q) { er[q] = nr_[q]; ei[q] = ni_[q]; }
            }
        } else {
            const int nconv = (G > NSCAN) ? G - NSCAN : G, ci = (G > NSCAN) ? vcu - NSCAN : vcu;
            const int g_lo = (int)(((long)ci * (T / 8)) / nconv), g_hi = (int)(((long)(ci + 1) * (T / 8)) / nconv);
            LAS float* yl = (LAS float*)lds;
            const int c = tid;
            float wk[CW];
#pragma unroll
            for (int k = 0; k < CW; ++k) wk[k] = args.in[3][k * DC + c];
            const float cb = args.in[4][c];
            float win[38];
#pragma unroll
            for (int k = 0; k < 38; ++k) win[k] = 0.f;
            {
                const int t0 = g_lo * 8;
#pragma unroll
                for (int k = 0; k < 30; ++k) { const int t = t0 - 30 + k; float hv = 0.f;
                    if (t >= 0 && (t >> 12) == (t0 >> 12)) { const size_t o = (size_t)t * 1024 + c; hv = bf2f(CV[o]) * sigmoidf_(bf2f(CV[o + 512])); }
                    win[k] = hv; }
            }
            int rows = 0, row_t0 = g_lo * 8;
            for (int gi = g_lo; gi < g_hi; ++gi) {
                const int t0 = gi * 8;
                if ((t0 & (SEQ - 1)) == 0) {
#pragma unroll
                    for (int k = 0; k < 30; ++k) win[k] = 0.f; }
#pragma unroll
                for (int j = 0; j < 8; ++j) { const size_t o = (size_t)(t0 + j) * 1024 + c; win[30 + j] = bf2f(CV[o]) * sigmoidf_(bf2f(CV[o + 512])); }
#pragma unroll
                for (int j = 0; j < 8; ++j) { float a = cb;
#pragma unroll
                    for (int k = 0; k < CW; ++k) a += wk[k] * win[j + k];
                    yl[(rows + j) * 512 + c] = a; }
#pragma unroll
                for (int k = 0; k < 30; ++k) win[k] = win[k + 8];
                rows += 8;
                if (rows == 40 || gi + 1 == g_hi) {
                    __syncthreads();
                    for (int r = wave; r < rows; r += NWAVES) {
                        float v[8]; float s = 0.f;
#pragma unroll
                        for (int j = 0; j < 8; ++j) { v[j] = yl[r * 512 + lane + 64 * j]; s += v[j]; }
                        const float mean = wave_sum(s) * (1.0f / 512.0f); float s2 = 0.f;
#pragma unroll
                        for (int j = 0; j < 8; ++j) { v[j] -= mean; s2 += v[j] * v[j]; }
                        const float rstd = 1.0f / sqrtf(wave_sum(s2) * (1.0f / 512.0f) + EPS); float s3 = 0.f;
#pragma unroll
                        for (int j = 0; j < 8; ++j) { const int cc = lane + 64 * j; float y = v[j] * rstd * args.in[5][cc] + args.in[6][cc]; y = y * sigmoidf_(y); v[j] = y; s3 += y * y; }
                        const float rr = 1.0f / sqrtf(wave_sum(s3) * (1.0f / 512.0f) + EPS);
#pragma unroll
                        for (int j = 0; j < 8; ++j) { const int cc = lane + 64 * j; MERGED[(size_t)(row_t0 + r) * 1024 + cc] = (bf16)f2bf(v[j] * rr * args.in[17][cc]); }
                    }
                    __syncthreads();
                    row_t0 += rows; rows = 0;
                }
            }
        }
        if (BOTH(3)) GRID_BAR();
    }

    if (IN(4)) {
        constexpr int TPG = (NCH / 64) * 4, TILES = NG * TPG;
        for (int t = gw; t < TILES; t += ngw) {
            const int g = t / TPG, q = t % TPG, m0 = (q >> 2) * 64, n0 = (q & 3) * 64;
            const bf16* ar[4]; const bf16* br[4];
#pragma unroll
            for (int i = 0; i < 4; ++i) { ar[i] = AS + ((size_t)(g * NCH + m0 + 16 * i + fr)) * 384 + fq * 8; br[i] = SSM_W2 + ((size_t)(g * 256 + n0 + 16 * i + fr)) * 384 + fq * 8; }
            f32x4 acc[4][4]; zero_acc(acc);
            wave_mma<4, 4>(ar, br, 384, acc);
#pragma unroll
            for (int i = 0; i < 4; ++i)
#pragma unroll
                for (int j = 0; j < 4; ++j) { const int r = m0 + 16 * i + fr, n = n0 + 16 * j + 4 * fq, ti = n >> 4, h = n & 15;
                    const v2u uu = *(const v2u*)(AS + ((size_t)(g * NCH + r)) * 384 + n);
                    const f32x4 dd = *(const f32x4*)(args.in[14] + g * 16 + h);
                    const float y0 = acc[i][j][0] + dd[0] * bflo(uu.x), y1 = acc[i][j][1] + dd[1] * bfhi(uu.x), y2 = acc[i][j][2] + dd[2] * bflo(uu.y), y3 = acc[i][j][3] + dd[3] * bfhi(uu.y);
                    v2u w; w.x = pk2(gelu_tanh(y0), gelu_tanh(y1)); w.y = pk2(gelu_tanh(y2), gelu_tanh(y3));
                    *(v2u*)(Z + ((size_t)(r * 16 + ti)) * 512 + g * 16 + h) = w; }
        }
        if (BOTH(4)) GRID_BAR();
    }

    if (IN(5)) {
        constexpr int NT = 512 / 64, TILES = (T / 64) * NT;
        for (int t = gw; t < TILES; t += ngw) {
            const int m0 = (t / NT) * 64, n0 = (t % NT) * 64;
            const bf16* ar[4]; const bf16* br[4];
#pragma unroll
            for (int i = 0; i < 4; ++i) { ar[i] = Z + (size_t)(m0 + 16 * i + fr) * 512 + fq * 8; br[i] = W_GLU_T + (size_t)(n0 + 16 * i + fr) * 512 + fq * 8; }
            f32x4 acc[4][4]; zero_acc(acc);
            wave_mma<4, 4>(ar, br, 512, acc);
#pragma unroll
            for (int i = 0; i < 4; ++i)
#pragma unroll
                for (int j = 0; j < 4; ++j) { const int m = m0 + 16 * i + fr, n = n0 + 16 * j + 4 * fq;
                    const v2u zz = *(const v2u*)(Z + (size_t)m * 512 + n); const f32x4 bg = *(const f32x4*)(args.in[16] + n);
                    f32x4 o; o[0] = bflo(zz.x) * sigmoidf_(acc[i][j][0] + bg[0]); o[1] = bfhi(zz.x) * sigmoidf_(acc[i][j][1] + bg[1]);
                    o[2] = bflo(zz.y) * sigmoidf_(acc[i][j][2] + bg[2]); o[3] = bfhi(zz.y) * sigmoidf_(acc[i][j][3] + bg[3]);
                    *(f32x4*)(ZG + (size_t)m * 512 + n) = o; }
        }
        if (BOTH(5)) GRID_BAR();
    }

    if (IN(6)) {
        for (int m = gw; m < T; m += ngw) {
            const f32x4 a = *(const f32x4*)(ZG + (size_t)m * 512 + lane * 4), b = *(const f32x4*)(ZG + (size_t)m * 512 + 256 + lane * 4);
            float s = (a[0] * a[0] + a[1] * a[1]) + (a[2] * a[2] + a[3] * a[3]) + (b[0] * b[0] + b[1] * b[1]) + (b[2] * b[2] + b[3] * b[3]);
            const float rr = 1.0f / sqrtf(wave_sum(s) * (1.0f / 512.0f) + EPS);
            const f32x4 ga = *(const f32x4*)(args.in[18] + lane * 4), gb = *(const f32x4*)(args.in[18] + 256 + lane * 4);
            v2u w; w.x = pk2(a[0] * rr * ga[0], a[1] * rr * ga[1]); w.y = pk2(a[2] * rr * ga[2], a[3] * rr * ga[3]);
            *(v2u*)(MERGED + (size_t)m * 1024 + 512 + lane * 4) = w;
            w.x = pk2(b[0] * rr * gb[0], b[1] * rr * gb[1]); w.y = pk2(b[2] * rr * gb[2], b[3] * rr * gb[3]);
            *(v2u*)(MERGED + (size_t)m * 1024 + 768 + lane * 4) = w;
        }
        if (BOTH(6)) GRID_BAR();
    }

#define GEMM_D_D(Aptr, Btptr, ...) do { \
        constexpr int NT = D / 64, TILES = (T / 64) * NT; \
        for (int t = gw; t < TILES; t += ngw) { \
            const int m0 = (t / NT) * 64, n0 = (t % NT) * 64; \
            const bf16* ar[4]; const bf16* br[4]; \
            _Pragma("unroll") for (int i = 0; i < 4; ++i) { ar[i] = (Aptr) + (size_t)(m0 + 16 * i + fr) * D + fq * 8; br[i] = (Btptr) + (size_t)(n0 + 16 * i + fr) * D + fq * 8; } \
            f32x4 acc[4][4]; zero_acc(acc); \
            wave_mma<4, 4>(ar, br, D, acc); \
            _Pragma("unroll") for (int i = 0; i < 4; ++i) _Pragma("unroll") for (int j = 0; j < 4; ++j) { const int m = m0 + 16 * i + fr, n = n0 + 16 * j + 4 * fq; const f32x4 v = acc[i][j]; __VA_ARGS__ } \
        } } while (0)

#define LN_ROWS(SRC, GAIN, BIAS, DSTF, DSTB) do { \
        for (int m = gw; m < T; m += ngw) { \
            f32x4 v[4]; float s = 0.f; \
            _Pragma("unroll") for (int j = 0; j < 4; ++j) { v[j] = *(const f32x4*)((SRC) + (size_t)m * D + j * 256 + lane * 4); s += (v[j][0] + v[j][1]) + (v[j][2] + v[j][3]); } \
            const float mean = wave_sum(s) * (1.0f / D); float s2 = 0.f; \
            _Pragma("unroll") for (int j = 0; j < 4; ++j) { v[j] = v[j] - mean; s2 += (v[j][0] * v[j][0] + v[j][1] * v[j][1]) + (v[j][2] * v[j][2] + v[j][3] * v[j][3]); } \
            const float rstd = 1.0f / sqrtf(wave_sum(s2) * (1.0f / D) + EPS); \
            _Pragma("unroll") for (int j = 0; j < 4; ++j) { const f32x4 gg = *(const f32x4*)((GAIN) + j * 256 + lane * 4), bb = *(const f32x4*)((BIAS) + j * 256 + lane * 4); \
                const f32x4 o = v[j] * rstd * gg + bb; *(f32x4*)((DSTF) + (size_t)m * D + j * 256 + lane * 4) = o; \
                if ((DSTB) != nullptr) { v2u w; w.x = pk2(o[0], o[1]); w.y = pk2(o[2], o[3]); *(v2u*)((DSTB) + (size_t)m * D + j * 256 + lane * 4) = w; } } \
        } } while (0)

    if (IN(7)) {
        pg8::DenseSched S; S.init(MERGED, W_OUT_T, T, D, D, G, bx);
        EpiResF32 E{x, Y1};
        pg8::gemm_phase<EpiResF32, pg8::DenseSched, false>(lds, D, S, E);
        if (BOTH(7)) GRID_BAR();
    }
    if (IN(8)) {
        LN_ROWS(Y1, args.in[20], args.in[21], X1, X1B);
        if (BOTH(8)) GRID_BAR();
    }
    if (IN(9)) {
        pg8::DenseSched S; S.init(X1B, WQ_T, T, D, D, G, bx);
        EpiBf16S E{Q, 0.0625f};
        pg8::gemm_phase<EpiBf16S, pg8::DenseSched, false>(lds, D, S, E);
        if (BOTH(9)) GRID_BAR();
    }
    if (IN(10)) {
        for (int u = gw; u < NB * NXH * (SEQ / 16); u += ngw) {
            const int bh = u / (SEQ / 16), qt = u % (SEQ / 16), b = bh >> 2, h = bh & 3;
            const bf16* qrow = Q + (size_t)(b * SEQ + qt * 16 + fr) * D + h * XHD + fq * 8;
            bf16x8 qf[8];
#pragma unroll
            for (int ks = 0; ks < 8; ++ks) qf[ks] = *(const bf16x8*)(qrow + ks * 32);
            f32x4 s[16];
#pragma unroll
            for (int nt = 0; nt < 16; ++nt) { s[nt] = (f32x4){0.f, 0.f, 0.f, 0.f};
                const bf16* krow = KB + (size_t)(b * MEML + nt * 16 + fr) * D + h * XHD + fq * 8;
#pragma unroll
                for (int ks = 0; ks < 8; ++ks) { const bf16x8 kf = *(const bf16x8*)(krow + ks * 32); s[nt] = __builtin_amdgcn_mfma_f32_16x16x32_bf16(kf, qf[ks], s[nt], 0, 0, 0); } }
            float mx = -3.0e38f;
#pragma unroll
            for (int nt = 0; nt < 16; ++nt) mx = fmaxf(mx, fmaxf(fmaxf(s[nt][0], s[nt][1]), fmaxf(s[nt][2], s[nt][3])));
            mx = fmaxf(mx, __shfl_xor(mx, 16)); mx = fmaxf(mx, __shfl_xor(mx, 32));
            float sum = 0.f;
#pragma unroll
            for (int nt = 0; nt < 16; ++nt) {
#pragma unroll
                for (int r = 0; r < 4; ++r) { const float e = __expf(s[nt][r] - mx); s[nt][r] = e; sum += e; } }
            sum += __shfl_xor(sum, 16); sum += __shfl_xor(sum, 32);
            const float inv = 1.0f / sum;
            bf16x8 pf[8];
#pragma unroll
            for (int ks = 0; ks < 8; ++ks) { v4u w; w.x = pk2(s[2 * ks][0] * inv, s[2 * ks][1] * inv); w.y = pk2(s[2 * ks][2] * inv, s[2 * ks][3] * inv);
                w.z = pk2(s[2 * ks + 1][0] * inv, s[2 * ks + 1][1] * inv); w.w = pk2(s[2 * ks + 1][2] * inv, s[2 * ks + 1][3] * inv); pf[ks] = __builtin_bit_cast(bf16x8, w); }
            bf16* orow = O + (size_t)(b * SEQ + qt * 16 + fr) * D + h * XHD + 4 * fq;
#pragma unroll
            for (int dt = 0; dt < 16; ++dt) { f32x4 o = (f32x4){0.f, 0.f, 0.f, 0.f};
                const bf16* vrow = VT + ((size_t)(b * 1024 + h * XHD + dt * 16 + fr)) * 256 + 4 * fq;
#pragma unroll
                for (int ks = 0; ks < 8; ++ks) { const v2u lo2 = *(const v2u*)(vrow + ks * 32), hi2 = *(const v2u*)(vrow + ks * 32 + 16);
                    v4u w; w.x = lo2.x; w.y = lo2.y; w.z = hi2.x; w.w = hi2.y;
                    o = __builtin_amdgcn_mfma_f32_16x16x32_bf16(__builtin_bit_cast(bf16x8, w), pf[ks], o, 0, 0, 0); }
                v2u w; w.x = pk2(o[0], o[1]); w.y = pk2(o[2], o[3]); *(v2u*)(orow + dt * 16) = w; }
        }
        if (BOTH(10)) GRID_BAR();
    }
    if (IN(11)) {
        pg8::DenseSched S; S.init(O, WO_T, T, D, D, G, bx);
        EpiResF32 E{X1, Y1};
        pg8::gemm_phase<EpiResF32, pg8::DenseSched, false>(lds, D, S, E);
        if (BOTH(11)) GRID_BAR();
    }
    if (IN(12)) {
        LN_ROWS(Y1, args.in[26], args.in[27], X2, X2B);
        if (BOTH(12)) GRID_BAR();
    }
    if (IN(13)) {
        constexpr int NT = NE / 64, TILES = (T / 64) * NT;
        for (int t = gw; t < TILES; t += ngw) {
            const int m0 = (t / NT) * 64, n0 = (t % NT) * 64;
            const bf16* ar[4]; const bf16* br[4];
#pragma unroll
            for (int i = 0; i < 4; ++i) { ar[i] = X2B + (size_t)(m0 + 16 * i + fr) * D + fq * 8; br[i] = WR_T + (size_t)(n0 + 16 * i + fr) * D + fq * 8; }
            f32x4 acc[4][4]; zero_acc(acc);
            wave_mma<4, 4>(ar, br, D, acc);
#pragma unroll
            for (int i = 0; i < 4; ++i)
#pragma unroll
                for (int j = 0; j < 4; ++j) *(f32x4*)(LOGITS + (size_t)(m0 + 16 * i + fr) * NE + n0 + 16 * j + 4 * fq) = acc[i][j];
        }
        if (BOTH(13)) GRID_BAR();
    }
    if (IN(14)) {
        const f32x4 rb = *(const f32x4*)(args.in[29] + lane * 4);
        for (int m = gw; m < T; m += ngw) {
            const f32x4 lg = *(const f32x4*)(LOGITS + (size_t)m * NE + lane * 4);
            float sc[4], bs[4];
#pragma unroll
            for (int r = 0; r < 4; ++r) { sc[r] = sigmoidf_(lg[r]); bs[r] = sc[r] + rb[r]; }
            float m1 = fmaxf(bs[0], bs[1]), m2 = fminf(bs[0], bs[1]);
            { const float a = bs[2]; const float n1 = fmaxf(m1, a); m2 = fmaxf(m2, fminf(m1, a)); m1 = n1; }
            { const float a = bs[3]; const float n1 = fmaxf(m1, a); m2 = fmaxf(m2, fminf(m1, a)); m1 = n1; }
#pragma unroll
            for (int o = 1; o < 8; o <<= 1) { const float o1 = __shfl_xor(m1, o), o2 = __shfl_xor(m2, o); const float n1 = fmaxf(m1, o1); m2 = fmaxf(fminf(m1, o1), fmaxf(m2, o2)); m1 = n1; }
            const float gs = m1 + m2; const int myg = lane >> 3;
            int rank = 0;
#pragma unroll
            for (int g2 = 0; g2 < 8; ++g2) { const float og = __shfl(gs, g2 * 8); rank += (og > gs || (og == gs && g2 < myg)) ? 1 : 0; }
            const bool sel = rank < TKG;
            float mv[4];
#pragma unroll
            for (int r = 0; r < 4; ++r) mv[r] = sel ? bs[r] : -3.0e38f;
            int my_e = 0; float my_sc = 0.f; float gsum = 0.f;
#pragma unroll
            for (int k = 0; k < TOPK; ++k) {
                float bv = mv[0]; int bi = 0;
#pragma unroll
                for (int r = 1; r < 4; ++r) if (mv[r] > bv) { bv = mv[r]; bi = r; }
                int be = lane * 4 + bi;
#pragma unroll
                for (int o = 1; o < 64; o <<= 1) { const float ov = __shfl_xor(bv, o); const int oe = __shfl_xor(be, o); if (ov > bv || (ov == bv && oe < be)) { bv = ov; be = oe; } }
                const int wl = be >> 2, wr_ = be & 3;
                float wsc = (wr_ == 0) ? sc[0] : (wr_ == 1) ? sc[1] : (wr_ == 2) ? sc[2] : sc[3];
                wsc = __shfl(wsc, wl);
                if (lane == wl) {
#pragma unroll
                    for (int r = 0; r < 4; ++r) if (r == wr_) mv[r] = -3.0e38f; }
                gsum += wsc;
                if (lane == k) { my_e = be; my_sc = wsc; }
            }
            if (lane < TOPK) { const unsigned pos = __hip_atomic_fetch_add(CNT + my_e, 1u, RLX_AGENT);
                TOPE[m * 8 + lane] = my_e; TOPP[m * 8 + lane] = (int)pos; GATE[m * 8 + lane] = ROUTED_SCALE * my_sc / gsum; }
        }
        if (BOTH(14)) GRID_BAR();
    }
#define MOE_OFFSETS() LAS int* off = (LAS int*)(lds + 132096); LAS int* tst = off + 260; \
        __syncthreads(); \
        if (tid < 64) { int c4[4]; int s = 0, s2 = 0; \
            _Pragma("unroll") for (int r = 0; r < 4; ++r) { c4[r] = (int)__hip_atomic_load(CNT + tid * 4 + r, RLX_AGENT); s += c4[r]; s2 += (c4[r] + 255) >> 8; } \
            int ps = s, ps2 = s2; \
            _Pragma("unroll") for (int o = 1; o < 64; o <<= 1) { const int a = __shfl_up(ps, o), a2 = __shfl_up(ps2, o); if (lane >= o) { ps += a; ps2 += a2; } } \
            int e0 = ps - s, t0 = ps2 - s2; \
            _Pragma("unroll") for (int r = 0; r < 4; ++r) { off[tid * 4 + r] = e0; tst[tid * 4 + r] = t0; e0 += c4[r]; t0 += (c4[r] + 255) >> 8; } \
            if (tid == 63) { off[256] = e0; tst[256] = t0; } } \
        __syncthreads();

    if (IN(15)) {
        MOE_OFFSETS();
        for (int a = gtid; a < NASSIGN; a += ngt) { const int e = TOPE[a], sl = off[e] + TOPP[a]; SLOT[a] = sl; STOK[sl] = a >> 3; SGATE[sl] = GATE[a]; }
        for (int t = gtid; t < T; t += ngt) STOK[NASSIGN + t] = t;
        if (BOTH(15)) GRID_BAR();
    }
    if (IN(16)) {
        MOE_OFFSETS();
        const int nmoe = tst[256];
        MoeSched<true> S{X2B, X2B, WGU_T, SH_GU_T, STOK, off, tst, nmoe, (nmoe + T / 256) * 2, G, bx, lds + 135168};
        EpiGateUp E{H, HS};
        pg8::gemm_phase<EpiGateUp, MoeSched<true>, true>(lds, D, S, E);
        if (BOTH(16)) GRID_BAR();
    }
    if (IN(17)) {
        MOE_OFFSETS();
        const int nmoe = tst[256];
        MoeSched<false> S{H, HS, WD_T, SH_D_T, STOK, off, tst, nmoe, (nmoe + T / 256) * 4, G, bx, lds + 135168};
        EpiDown E{Y, YS, SGATE};
        pg8::gemm_phase<EpiDown, MoeSched<false>, true>(lds, DE, S, E);
        if (BOTH(17)) GRID_BAR();
    }
    if (IN(18)) {
        for (int m = gw; m < T; m += ngw) {
            f32x4 v[4];
#pragma unroll
            for (int j = 0; j < 4; ++j) { v[j] = *(const f32x4*)(X2 + (size_t)m * D + j * 256 + lane * 4) * ALPHA;
                const v2u ys = *(const v2u*)(YS + (size_t)m * D + j * 256 + lane * 4); v[j][0] += bflo(ys.x); v[j][1] += bfhi(ys.x); v[j][2] += bflo(ys.y); v[j][3] += bfhi(ys.y); }
#pragma unroll
            for (int k = 0; k < TOPK; ++k) { const int sl = SLOT[m * 8 + k];
#pragma unroll
                for (int j = 0; j < 4; ++j) { const v2u yy = *(const v2u*)(Y + (size_t)sl * D + j * 256 + lane * 4); v[j][0] += bflo(yy.x); v[j][1] += bfhi(yy.x); v[j][2] += bflo(yy.y); v[j][3] += bfhi(yy.y); } }
            float s = 0.f;
#pragma unroll
            for (int j = 0; j < 4; ++j) s += (v[j][0] + v[j][1]) + (v[j][2] + v[j][3]);
            const float mean = wave_sum(s) * (1.0f / D); float s2 = 0.f;
#pragma unroll
            for (int j = 0; j < 4; ++j) { v[j] = v[j] - mean; s2 += (v[j][0] * v[j][0] + v[j][1] * v[j][1]) + (v[j][2] * v[j][2] + v[j][3] * v[j][3]); }
            const float rstd = 1.0f / sqrtf(wave_sum(s2) * (1.0f / D) + EPS);
#pragma unroll
            for (int j = 0; j < 4; ++j) { const f32x4 gg = *(const f32x4*)(args.in[36] + j * 256 + lane * 4), bb = *(const f32x4*)(args.in[37] + j * 256 + lane * 4);
                *(f32x4*)(args.out + (size_t)m * D + j * 256 + lane * 4) = v[j] * rstd * gg + bb; }
        }
    }
#undef IN
#undef BOTH
}

extern "C" void kernel_launch(void* const* d_in, const int* in_sizes, int n_in, void* d_out, int out_size, void* d_ws, size_t ws_size, hipStream_t stream) {
    static int grid = 0;
    if (grid == 0) {
        if (n_in != 38 || out_size != T * D || ws_size < WS_END) { fprintf(stderr, "kernel_launch: unexpected shapes (n_in %d, out %d, ws %zu)\n", n_in, out_size, ws_size); grid = -1; return; }
        int dev = 0, cus = 0, per_cu = 0;
        if (hipGetDevice(&dev) != hipSuccess || hipDeviceGetAttribute(&cus, hipDeviceAttributeMultiprocessorCount, dev) != hipSuccess) { grid = -1; return; }
        if (hipFuncSetAttribute((const void*)fwd, hipFuncAttributeMaxDynamicSharedMemorySize, LDS_BYTES) != hipSuccess) { fprintf(stderr, "kernel_launch: hipFuncSetAttribute failed\n"); grid = -1; return; }
        if (hipOccupancyMaxActiveBlocksPerMultiprocessor(&per_cu, (const void*)fwd, NTHR, LDS_BYTES) != hipSuccess || per_cu < 1) { fprintf(stderr, "kernel_launch: occupancy query says %d\n", per_cu); }
        (void)hipGetLastError();
        grid = cus;
    }
    if (grid < 0) return;
    (void)hipMemsetAsync((char*)d_ws + WS_CTL, 0, CTL_ZERO_BYTES, stream);
    Args a{};
    for (int i = 0; i < 38; ++i) a.in[i] = (const float*)d_in[i];
    a.out = (float*)d_out; a.ws = (unsigned char*)d_ws;
#if MK_SPLIT
    for (int p = 0; p < N_PHASES; ++p) { a.ph_lo = p; a.ph_hi = p + 1; hipLaunchKernelGGL(fwd, dim3(grid), dim3(NTHR), LDS_BYTES, stream, a); }
#else
    a.ph_lo = 0; a.ph_hi = N_PHASES;
    hipLaunchKernelGGL(fwd, dim3(grid), dim3(NTHR), LDS_BYTES, stream, a);
#endif
}
```

```cpp
#include <hip/hip_runtime.h>
#include <cstdio>
#include <cstdint>

#ifndef MK_SPLIT
#define MK_SPLIT 0
#endif

#define GAS __attribute__((address_space(1)))
#define LAS __attribute__((address_space(3)))
typedef unsigned short bf16;
typedef short bf16x8 __attribute__((ext_vector_type(8)));
typedef float f32x4 __attribute__((ext_vector_type(4)));
typedef unsigned v4u __attribute__((ext_vector_type(4)));
typedef unsigned v2u __attribute__((ext_vector_type(2)));
#define RLX_AGENT __ATOMIC_RELAXED, __HIP_MEMORY_SCOPE_AGENT
#define LDS_WAIT() asm volatile("s_waitcnt lgkmcnt(0)" ::: "memory")

constexpr int NB = 4, SEQ = 4096, T = NB * SEQ, D = 1024;
constexpr int DC = 512, DS = 512, CW = 31, NG = 32, GH = 16, PS = 64;
constexpr int LC = 16, NCH = T / LC;
constexpr int MEML = 256, NXH = 4, XHD = 256;
constexpr int NE = 256, TOPK = 8, NEG = 8, TKG = 4, DE = 256;
constexpr int NASSIGN = T * TOPK;
constexpr float ALPHA = 1.189207115002721f;
constexpr float EPS = 1e-5f;
constexpr float ROUTED_SCALE = 2.5f;
constexpr int NWAVES = 8, NTHR = 512;

constexpr size_t MiB = 1u << 20;
constexpr size_t WS_CTL = 0, CTL_ZERO_BYTES = 1 * MiB;
constexpr size_t WS_W_IN_T = 1 * MiB;
constexpr size_t WS_W_GLU_T = 4 * MiB;
constexpr size_t WS_W_OUT_T = 5 * MiB;
constexpr size_t WS_WQ_T = 7 * MiB;
constexpr size_t WS_WKV_T = 9 * MiB;
constexpr size_t WS_WO_T = 13 * MiB;
constexpr size_t WS_WR_T = 15 * MiB;
constexpr size_t WS_SSM_W1 = 16 * MiB;
constexpr size_t WS_SSM_W2 = 18 * MiB;
constexpr size_t WS_SH_GU_T = 24 * MiB;
constexpr size_t WS_SH_D_T = 25 * MiB;
constexpr size_t WS_LAM16 = 25 * MiB + 512 * 1024;
constexpr size_t WS_MEMB = 26 * MiB;
constexpr size_t WS_KB = 28 * MiB;
constexpr size_t WS_VT = 30 * MiB;
constexpr size_t WS_WGU_T = 32 * MiB;
constexpr size_t WS_WD_T = 288 * MiB;
constexpr size_t WS_X2 = 416 * MiB;
constexpr size_t WS_X2B = 480 * MiB;
constexpr size_t WS_Y = 512 * MiB;
constexpr size_t WS_XB = 512 * MiB;
constexpr size_t WS_CV = 544 * MiB;
constexpr size_t WS_AS = 576 * MiB;
constexpr size_t WS_SEND = 600 * MiB;
constexpr size_t WS_Z = 616 * MiB;
constexpr size_t WS_ZG = 632 * MiB;
constexpr size_t WS_MERGED = 664 * MiB;
constexpr size_t WS_Y1 = 696 * MiB;
constexpr size_t WS_H = 768 * MiB;
constexpr size_t WS_Q = 768 * MiB;
constexpr size_t WS_O = 800 * MiB;
constexpr size_t WS_X1 = 832 * MiB;
constexpr size_t WS_X1B = 896 * MiB;
constexpr size_t WS_YS = 840 * MiB;
constexpr size_t WS_HS = 832 * MiB;
constexpr size_t WS_LOGITS = 872 * MiB;
constexpr size_t WS_TOPE = 928 * MiB;
constexpr size_t WS_TOPP = 928 * MiB + 512 * 1024;
constexpr size_t WS_GATE = 929 * MiB;
constexpr size_t WS_SLOT = 929 * MiB + 512 * 1024;
constexpr size_t WS_STOK = 930 * MiB;
constexpr size_t WS_SGATE = 931 * MiB;
constexpr size_t WS_END = 932 * MiB;
static_assert(WS_HS == WS_H + (size_t)NASSIGN * 256 * 2, "HS follows H");
constexpr int CW_BAR = 4096;
constexpr int CW_CNT = 16384;

constexpr int LDS_BYTES = 147456;
constexpr int MISC_OFF = 131072 + 320;

__device__ __forceinline__ unsigned f2bf(float f) { unsigned u = __builtin_bit_cast(unsigned, f); return (u + 0x7fffu + ((u >> 16) & 1u)) >> 16; }
__device__ __forceinline__ unsigned pk2(float lo, float hi) { return f2bf(lo) | (f2bf(hi) << 16); }
__device__ __forceinline__ float bf2f(unsigned h) { return __builtin_bit_cast(float, h << 16); }
__device__ __forceinline__ float bflo(unsigned w) { return __builtin_bit_cast(float, w << 16); }
__device__ __forceinline__ float bfhi(unsigned w) { return __builtin_bit_cast(float, w & 0xffff0000u); }
typedef float f32x2_t __attribute__((ext_vector_type(2)));
typedef __bf16 bf16x2_t __attribute__((ext_vector_type(2)));
__device__ __forceinline__ unsigned cvtpk(float lo, float hi) { f32x2_t v = {lo, hi}; bf16x2_t b = __builtin_convertvector(v, bf16x2_t); return __builtin_bit_cast(unsigned, b); }
__device__ __forceinline__ float sigmoidf_(float x) { return __builtin_amdgcn_rcpf(1.0f + __expf(-x)); }
__device__ __forceinline__ float wave_sum(float v) {
#pragma unroll
    for (int o = 1; o < 64; o <<= 1) v += __shfl_xor(v, o);
    return v;
}
__device__ __forceinline__ float gelu_tanh(float x) {
    const float u = 0.7978845608028654f * (x + 0.044715f * x * x * x);
    const float t = 1.0f - 2.0f / (1.0f + __expf(2.0f * u));
    return 0.5f * x * (1.0f + t);
}

#define XB_TMO      128
#define XB_XCNT(j)  (256  + 64 * (j))
#define XB_XSUB(j)  (1280 + 64 * (j))
#define XB_XGEN(j)  (2304 + 64 * (j))
#define XB_TOP      3328
#define XB_TOPGEN   3392
#define XCD_BAR_WORDS 3456
#define XB_SPIN_CAP (1u << 20)

__device__ __forceinline__ unsigned xb_ld(unsigned* p)              { return __hip_atomic_load(p, __ATOMIC_RELAXED, __HIP_MEMORY_SCOPE_AGENT); }
__device__ __forceinline__ unsigned xb_add(unsigned* p, unsigned v) { return __hip_atomic_fetch_add(p, v, __ATOMIC_RELAXED, __HIP_MEMORY_SCOPE_AGENT); }
__device__ __forceinline__ unsigned xb_xcc_id() { return (unsigned)__builtin_amdgcn_s_getreg((3 << 11) | 20) & 0xFu; }
#define XB_SPIN(cond, bar) do { unsigned _sp = 0; while (cond) { __builtin_amdgcn_s_sleep(1); \
    if ((++_sp & 255u) == 0u) { if (xb_ld(&(bar)[XB_TMO])) break; if (_sp > XB_SPIN_CAP) { atomicAdd(&(bar)[XB_TMO], 1u); break; } } } } while (0)

struct XcdBarrier { unsigned* bar; unsigned x; volatile LAS unsigned* st; };

__device__ __forceinline__ XcdBarrier xcd_barrier_post(unsigned* bar, volatile LAS unsigned* st) {
    XcdBarrier b; b.bar = bar; b.x = xb_xcc_id(); b.st = st;
    if (threadIdx.x == 0) (void)xb_add(&bar[XB_XCNT(b.x)], 1u);
    return b;
}
__device__ __forceinline__ void xcd_barrier_complete(unsigned* bar, unsigned x, unsigned& nloc, unsigned& nx) {
    const unsigned G = gridDim.x * gridDim.y * gridDim.z;
    unsigned sum, cnt, mine, sp = 0u;
    for (;;) {
        sum = 0u; cnt = 0u; mine = 0u;
#pragma unroll
        for (unsigned j = 0; j < 16; ++j) { const unsigned c = xb_ld(&bar[XB_XCNT(j)]); sum += c; cnt += (c > 0u) ? 1u : 0u; mine = (j == x) ? c : mine; }
        if (sum == G) break;
        __builtin_amdgcn_s_sleep(1);
        if ((++sp & 255u) == 0u) { if (xb_ld(&bar[XB_TMO])) break; if (sp > XB_SPIN_CAP) { atomicAdd(&bar[XB_TMO], 1u); break; } }
    }
    nloc = mine > 0u ? mine : 1u; nx = cnt > 0u ? cnt : 1u;
}
__device__ __forceinline__ void xcd_barrier(const XcdBarrier& b) {
    asm volatile("s_waitcnt vmcnt(0)" ::: "memory");
    __syncthreads();
    if (threadIdx.x == 0) {
        unsigned* bar = b.bar;
        __builtin_amdgcn_s_waitcnt(0);
        unsigned nloc = b.st[0], nx = b.st[1];
        if (nloc == 0u) { xcd_barrier_complete(bar, b.x, nloc, nx); b.st[0] = nloc; b.st[1] = nx; }
        const unsigned old = xb_add(&bar[XB_XSUB(b.x)], 1u);
        const unsigned gen = old / nloc;
        if (old + 1u == (gen + 1u) * nloc) {
            __builtin_amdgcn_fence(__ATOMIC_RELEASE, "agent");
            asm volatile("s_waitcnt vmcnt(0)" ::: "memory");
            const unsigned og = xb_add(&bar[XB_TOP], 1u);
            const unsigned tg = og / nx;
            if (og + 1u == (tg + 1u) * nx) xb_add(&bar[XB_TOPGEN], 1u);
            else XB_SPIN(xb_ld(&bar[XB_TOPGEN]) == tg, bar);
            __builtin_amdgcn_fence(__ATOMIC_ACQUIRE, "agent");
            xb_add(&bar[XB_XGEN(b.x)], 1u);
            asm volatile("s_waitcnt vmcnt(0)" ::: "memory");
        } else {
            XB_SPIN(xb_ld(&bar[XB_XGEN(b.x)]) == gen, bar);
            __builtin_amdgcn_fence(__ATOMIC_ACQUIRE, "agent");
            asm volatile("s_waitcnt vmcnt(0)" ::: "memory");
        }
    }
    __syncthreads();
}

template <int MI, int NJ>
__device__ __forceinline__ void wave_mma(const bf16* (&ar)[MI], const bf16* (&br)[NJ], int K, f32x4 (&acc)[MI][NJ]) {
#pragma unroll 2
    for (int k = 0; k < K; k += 32) {
        bf16x8 a[MI], b[NJ];
#pragma unroll
        for (int i = 0; i < MI; ++i) a[i] = *(const bf16x8*)(ar[i] + k);
#pragma unroll
        for (int j = 0; j < NJ; ++j) b[j] = *(const bf16x8*)(br[j] + k);
#pragma unroll
        for (int i = 0; i < MI; ++i)
#pragma unroll
            for (int j = 0; j < NJ; ++j) acc[i][j] = __builtin_amdgcn_mfma_f32_16x16x32_bf16(b[j], a[i], acc[i][j], 0, 0, 0);
    }
}
template <int MI, int NJ>
__device__ __forceinline__ void zero_acc(f32x4 (&acc)[MI][NJ]) {
#pragma unroll
    for (int i = 0; i < MI; ++i)
#pragma unroll
        for (int j = 0; j < NJ; ++j) acc[i][j] = (f32x4){0.f, 0.f, 0.f, 0.f};
}


namespace pg8 {
constexpr int BM = 256, BK = 64, HALF = 128, HTB = HALF * BK * 2, STAGE_BYTES = 8 * HTB, NXCD = 8, WGM = 8;
__host__ __device__ __forceinline__ int lds_byte(int r, int c) { const int st = (r >> 4) * 2 + (c >> 5), rr = r & 15, cc = c & 31, ob = rr * 64 + cc * 2; return st * 1024 + (ob ^ (((ob >> 9) & 1) << 5)); }
__host__ __device__ __forceinline__ void stage_rc(int b, int& R, int& C) { const int st = b / 1024, sb = b % 1024, swz = sb ^ (((sb >> 9) & 1) << 5); R = (st >> 1) * 16 + swz / 64; C = (st & 1) * 32 + (swz % 64) / 2; }
__host__ __device__ __forceinline__ int perm32(int rho) { const int n = rho >> 4, i = rho & 15; return 8 * (i >> 2) + 4 * n + (i & 3); }
__device__ __forceinline__ unsigned cvt_pk_bf16(float lo, float hi) { unsigned r; asm volatile("v_cvt_pk_bf16_f32 %0, %1, %2" : "=v"(r) : "v"(lo), "v"(hi)); return r; }

struct Unit { int pm, pn, e, base, cnt; };

template <class Epi, class Sched, bool ALIGN_EPI>
__device__ __forceinline__ void gemm_phase(LAS unsigned char* lds, const int K, const Sched& S, const Epi& E) {
    const int tid = threadIdx.x, wid = __builtin_amdgcn_readfirstlane(tid >> 6), lane = tid & 63, wr = wid >> 2, wc = wid & 3, fr = lane & 15, fq = lane >> 4;
    const int nt = K / BK;
    unsigned voffB[2];
#pragma unroll
    for (int i = 0; i < 2; ++i) { int R, C; stage_rc(tid * 16 + i * 8192, R, C); const int Rb = Epi::PERM ? ((R & ~31) + perm32(R & 31)) : R; voffB[i] = (unsigned)(Rb * K + C) * 2u; }
    const size_t kstep = (size_t)(BK * 2);
    const size_t hB = S.b_hstep(K);
    const unsigned ldsw = (unsigned)wid * 1024u;
    const int aoff = lds_byte(wr * 64 + fr, fq * 8), boff = lds_byte(wc * 32 + fr, fq * 8);
#define PG8_SA(b, h) (((b) * 2 + (h)) * HTB)
#define PG8_SB(b, h) ((4 + (b) * 2 + (h)) * HTB)
#define PG8_STAGE(bufoff, gbase, voff) do { _Pragma("unroll") for (int _i = 0; _i < 2; ++_i) \
        __builtin_amdgcn_global_load_lds((const unsigned*)((const char*)(gbase) + (voff)[_i]), (LAS unsigned*)(lds + (bufoff) + ldsw + _i * 8192), 16, 0, 0); } while (0)
#define PG8_LDA(dst, b, h) do { _Pragma("unroll") for (int m = 0; m < 4; ++m) _Pragma("unroll") for (int k = 0; k < 2; ++k) dst[m][k] = *(const LAS bf16x8*)(lds + PG8_SA(b, h) + aoff + m * 2048 + k * 1024); } while (0)
#define PG8_LDB(dst, b, h) do { _Pragma("unroll") for (int n = 0; n < 2; ++n) _Pragma("unroll") for (int k = 0; k < 2; ++k) dst[n][k] = *(const LAS bf16x8*)(lds + PG8_SB(b, h) + boff + n * 2048 + k * 1024); } while (0)
#define PG8_MMA(ai, bj, At, Bt) do { __builtin_amdgcn_s_setprio(1); _Pragma("unroll") for (int m = 0; m < 4; ++m) _Pragma("unroll") for (int n = 0; n < 2; ++n) _Pragma("unroll") for (int k = 0; k < 2; ++k) \
        acc[ai][bj][m][n] = __builtin_amdgcn_mfma_f32_16x16x32_bf16(Bt[n][k], At[m][k], acc[ai][bj][m][n], 0, 0, 0); __builtin_amdgcn_s_setprio(0); } while (0)
#define PG8_WAIT_V(n) asm volatile("s_waitcnt vmcnt(" #n ")" ::: "memory")
#define PG8_WAIT_L(n) asm volatile("s_waitcnt lgkmcnt(" #n ")" ::: "memory")
#define PG8_BAR __builtin_amdgcn_s_barrier()
#define PG8_SCHED __builtin_amdgcn_sched_barrier(0)
    Unit cur, nxt; int ui = 0;
    if (!S.next(0, cur)) return;
    f32x4 acc[2][2][4][2];
#pragma unroll
    for (int a = 0; a < 2; ++a)
#pragma unroll
        for (int b = 0; b < 2; ++b)
#pragma unroll
            for (int m = 0; m < 4; ++m)
#pragma unroll
                for (int n = 0; n < 2; ++n) acc[a][b][m][n] = (f32x4){0.f, 0.f, 0.f, 0.f};
    bf16x8 At[4][2], B0[2][2], B1[2][2];
    unsigned va[4], vn[4];
    S.a_off(cur, tid, K, va);
    const char* cA = S.a_base(cur); const char* cB = S.b_base(cur);
    PG8_STAGE(PG8_SB(0, 0), cB, voffB); PG8_STAGE(PG8_SB(0, 1), cB + hB, voffB); PG8_STAGE(PG8_SA(0, 0), cA, va); PG8_STAGE(PG8_SA(0, 1), cA, va + 2);
    if (wr == 1) PG8_BAR;
    PG8_WAIT_V(2); PG8_BAR;
    PG8_STAGE(PG8_SB(1, 0), cB + kstep, voffB); PG8_STAGE(PG8_SA(1, 0), cA + kstep, va); PG8_STAGE(PG8_SB(1, 1), cB + hB + kstep, voffB);
    PG8_WAIT_V(6); PG8_BAR;
    for (;;) {
        const bool has_next = S.next(ui + 1, nxt);
        const char* nA = has_next ? S.a_base(nxt) : cA; const char* nB = has_next ? S.b_base(nxt) : cB;
        if constexpr (Sched::EARLY_OFF) { if (has_next) S.a_pre(nxt, tid, vn); }
#pragma nounroll
        for (int t = 0; t < nt; t += 2) {
            const bool last = (t == nt - 2);
            const char* a1 = cA + (size_t)(t + 1) * kstep;
            const char* a2 = last ? nA : cA + (size_t)(t + 2) * kstep; const char* b2 = last ? nB : cB + (size_t)(t + 2) * kstep;
            const char* a3 = a2 + kstep; const char* b3 = b2 + kstep;
            PG8_LDB(B0, 0, 0); PG8_LDB(B1, 0, 1); PG8_SCHED; PG8_LDA(At, 0, 0); PG8_STAGE(PG8_SA(1, 1), a1, va + 2);
            PG8_WAIT_V(8); PG8_WAIT_L(0); PG8_BAR; PG8_MMA(0, 0, At, B0); PG8_MMA(0, 1, At, B1); PG8_BAR; PG8_SCHED;
            if (last) {
                if (has_next) { if constexpr (Sched::EARLY_OFF) S.a_fin(nxt, tid, K, vn, va); else S.a_off(nxt, tid, K, va); } }
            PG8_LDA(At, 0, 1); PG8_STAGE(PG8_SB(0, 0), b2, voffB); PG8_STAGE(PG8_SB(0, 1), b2 + hB, voffB); PG8_STAGE(PG8_SA(0, 0), a2, va);
            PG8_WAIT_V(8); PG8_WAIT_L(0); PG8_BAR; PG8_MMA(1, 0, At, B0); PG8_MMA(1, 1, At, B1); PG8_BAR; PG8_SCHED;
            PG8_LDB(B0, 1, 0); PG8_LDB(B1, 1, 1); PG8_SCHED; PG8_LDA(At, 1, 0); PG8_STAGE(PG8_SA(0, 1), a2, va + 2);
            PG8_WAIT_V(8); PG8_WAIT_L(0); PG8_BAR; PG8_MMA(0, 0, At, B0); PG8_MMA(0, 1, At, B1); PG8_BAR; PG8_SCHED;
            PG8_LDA(At, 1, 1); PG8_STAGE(PG8_SB(1, 0), b3, voffB); PG8_STAGE(PG8_SB(1, 1), b3 + hB, voffB); PG8_STAGE(PG8_SA(1, 0), a3, va);
            PG8_WAIT_V(8); PG8_WAIT_L(0); PG8_BAR; PG8_MMA(1, 0, At, B0); PG8_MMA(1, 1, At, B1); PG8_BAR; PG8_SCHED;
        }
        if constexpr (ALIGN_EPI) { if (wr == 0) PG8_BAR; }
        E(acc, cur, wr, wc, fr, fq);
        if (!has_next) break;
#pragma unroll
        for (int a = 0; a < 2; ++a)
#pragma unroll
            for (int b = 0; b < 2; ++b)
#pragma unroll
                for (int m = 0; m < 4; ++m)
#pragma unroll
                    for (int n = 0; n < 2; ++n) acc[a][b][m][n] = (f32x4){0.f, 0.f, 0.f, 0.f};
        cur = nxt; cA = nA; cB = nB; ++ui;
        if constexpr (ALIGN_EPI) { if (wr == 1) PG8_BAR; }
    }
    PG8_WAIT_V(0);
    if constexpr (!ALIGN_EPI) { if (wr == 0) PG8_BAR; }
    PG8_BAR;
#undef PG8_SA
#undef PG8_SB
#undef PG8_STAGE
#undef PG8_LDA
#undef PG8_LDB
#undef PG8_MMA
#undef PG8_WAIT_V
#undef PG8_WAIT_L
#undef PG8_BAR
#undef PG8_SCHED
}

__device__ __forceinline__ int xcd_deal(int i, int G, int c, int total) {
    const int per = (total + 7) >> 3, x = c & 7, j = i * (G >> 3) + (c >> 3);
    if (j >= per) return -1; const int u = x * per + j; return u < total ? u : -1;
}

struct DenseSched {
    static constexpr bool EARLY_OFF = false;
    const char* A; const char* Bt; int nM, nN, nwg, G, c, K;
    __device__ __forceinline__ void init(const void* A_, const void* Bt_, int M, int N, int K_, int G_, int c_) { A = (const char*)A_; Bt = (const char*)Bt_; nM = M / BM; nN = N / BM; nwg = nM * nN; G = G_; c = c_; K = K_; }
    __device__ __forceinline__ bool next(int i, Unit& u) const {
        const long L = (long)i * G + c; if (L >= nwg) return false;
        int wgid = (int)L; { const int q = nwg / NXCD, r = nwg % NXCD, xcd = wgid % NXCD, off = wgid / NXCD; wgid = (xcd < r ? xcd * (q + 1) : r * (q + 1) + (xcd - r) * q) + off; }
        const int nig = WGM * nN, gid = wgid / nig, fm = gid * WGM, gsz = (nM - fm) < WGM ? (nM - fm) : WGM;
        u.pm = fm + ((wgid % nig) % gsz); u.pn = (wgid % nig) / gsz; u.e = 0; u.base = u.pm * BM; u.cnt = BM; return true;
    }
    __device__ __forceinline__ const char* a_base(const Unit&) const { return A; }
    __device__ __forceinline__ void a_off(const Unit& u, int tid, int K_, unsigned (&vo)[4]) const {
        asm volatile("" : "+v"(tid)); int Ra[2], Ca[2]; stage_rc(tid * 16, Ra[0], Ca[0]); stage_rc(tid * 16 + 8192, Ra[1], Ca[1]);
#pragma unroll
        for (int h = 0; h < 2; ++h)
#pragma unroll
            for (int i = 0; i < 2; ++i) vo[h * 2 + i] = (unsigned)((u.pm * BM + h * HALF + Ra[i]) * K_ + Ca[i]) * 2u;
    }
    __device__ __forceinline__ const char* b_base(const Unit& u) const { return Bt + (size_t)u.pn * BM * K * 2; }
    __device__ __forceinline__ size_t b_hstep(int K_) const { return (size_t)HALF * K_ * 2; }
};
}

struct ProjSched {
    static constexpr bool EARLY_OFF = false;
    const char *XBp, *WINp, *MEMBp, *WKVp; int G, c;
    __device__ __forceinline__ bool next(int i, pg8::Unit& u) const {
        const int L = i * G + c; if (L >= 416) return false;
        int pm, pn, e;
        if (L < 384) { const int wgid = (L & 7) * 48 + (L >> 3);
            pm = (wgid / 48) * 8 + (wgid % 48) % 8; pn = (wgid % 48) / 8; e = 0; }
        else { const int q = L - 384; pm = q >> 3; pn = q & 7; e = 1; }
        u.pm = pm; u.pn = pn; u.e = e; u.base = pm * 256; u.cnt = 256;
        return true;
    }
    __device__ __forceinline__ const char* a_base(const pg8::Unit& u) const { return u.e ? MEMBp : XBp; }
    __device__ __forceinline__ void a_off(const pg8::Unit& u, int tid, int K_, unsigned (&vo)[4]) const {
        asm volatile("" : "+v"(tid)); int Ra[2], Ca[2]; pg8::stage_rc(tid * 16, Ra[0], Ca[0]); pg8::stage_rc(tid * 16 + 8192, Ra[1], Ca[1]);
#pragma unroll
        for (int h = 0; h < 2; ++h)
#pragma unroll
            for (int i = 0; i < 2; ++i) vo[h * 2 + i] = (unsigned)((u.pm * 256 + h * 128 + Ra[i]) * K_ + Ca[i]) * 2u;
    }
    __device__ __forceinline__ const char* b_base(const pg8::Unit& u) const { return (u.e ? WKVp : WINp) + (size_t)u.pn * 256 * 1024 * 2; }
    __device__ __forceinline__ size_t b_hstep(int K_) const { return (size_t)128 * K_ * 2; }
};
struct EpiProj {
    static constexpr bool PERM = true;
    bf16 *CV, *AS, *KB, *VT;
    __device__ __forceinline__ void operator()(const f32x4 (&acc)[2][2][4][2], const pg8::Unit& u, int wr, int wc, int fr, int fq) const {
        int r0 = wr * 64 + fr; asm volatile("" : "+v"(r0));
#pragma unroll
        for (int ai = 0; ai < 2; ++ai)
#pragma unroll
            for (int m = 0; m < 4; ++m) { const int row = u.pm * 256 + ai * 128 + m * 16 + r0;
#pragma unroll
                for (int bj = 0; bj < 2; ++bj) { const int col = u.pn * 256 + bj * 128 + wc * 32 + 8 * fq; const f32x4 v0 = acc[ai][bj][m][0], v1 = acc[ai][bj][m][1];
                    v4u w; w.x = cvtpk(v0[0], v0[1]); w.y = cvtpk(v0[2], v0[3]); w.z = cvtpk(v1[0], v1[1]); w.w = cvtpk(v1[2], v1[3]);
                    if (u.e == 0) { if (u.pn < 4) *(v4u*)(CV + (size_t)row * 1024 + col) = w;
                        else { const int ch = col - 1024, g = ch >> 4, h = ch & 15; *(v4u*)(AS + ((size_t)(g * NCH + (row >> 4)) * 384 + (row & 15) * 16 + h)) = w; } }
                    else { if (u.pn < 4) *(v4u*)(KB + (size_t)row * 1024 + col) = w;
                        else { const int d = col - 1024, b = row >> 8, key = row & 255; bf16* vp = VT + ((size_t)(b * 1024 + d)) * 256 + key;
                            vp[0 * 256] = (bf16)(w.x & 0xffffu); vp[1 * 256] = (bf16)(w.x >> 16); vp[2 * 256] = (bf16)(w.y & 0xffffu); vp[3 * 256] = (bf16)(w.y >> 16);
                            vp[4 * 256] = (bf16)(w.z & 0xffffu); vp[5 * 256] = (bf16)(w.z >> 16); vp[6 * 256] = (bf16)(w.w & 0xffffu); vp[7 * 256] = (bf16)(w.w >> 16); } } } }
    }
};
struct EpiResF32 {
    static constexpr bool PERM = false;
    const float* res; float* out;
    __device__ __forceinline__ void operator()(const f32x4 (&acc)[2][2][4][2], const pg8::Unit& u, int wr, int wc, int fr, int fq) const {
        int r0 = wr * 64 + fr; asm volatile("" : "+v"(r0));
#pragma unroll
        for (int ai = 0; ai < 2; ++ai)
#pragma unroll
            for (int m = 0; m < 4; ++m) { const size_t ro = (size_t)(u.pm * 256 + ai * 128 + m * 16 + r0) * D + u.pn * 256 + wc * 32 + 4 * fq;
#pragma unroll
                for (int bj = 0; bj < 2; ++bj)
#pragma unroll
                    for (int n = 0; n < 2; ++n) { const size_t o = ro + bj * 128 + n * 16; const f32x4 r = *(const f32x4*)(res + o); *(f32x4*)(out + o) = r * ALPHA + acc[ai][bj][m][n]; } }
    }
};
struct EpiBf16S {
    static constexpr bool PERM = true;
    bf16* out; float scale;
    __device__ __forceinline__ void operator()(const f32x4 (&acc)[2][2][4][2], const pg8::Unit& u, int wr, int wc, int fr, int fq) const {
        int r0 = wr * 64 + fr; asm volatile("" : "+v"(r0));
#pragma unroll
        for (int ai = 0; ai < 2; ++ai)
#pragma unroll
            for (int m = 0; m < 4; ++m) { const size_t ro = (size_t)(u.pm * 256 + ai * 128 + m * 16 + r0) * D + u.pn * 256 + wc * 32 + 8 * fq;
#pragma unroll
                for (int bj = 0; bj < 2; ++bj) { const f32x4 v0 = acc[ai][bj][m][0] * scale, v1 = acc[ai][bj][m][1] * scale;
                    v4u w; w.x = cvtpk(v0[0], v0[1]); w.y = cvtpk(v0[2], v0[3]); w.z = cvtpk(v1[0], v1[1]); w.w = cvtpk(v1[2], v1[3]);
                    *(v4u*)(out + ro + bj * 128) = w; } }
    }
};
template <bool GATEUP>
struct MoeSched {
    static constexpr int NPN = GATEUP ? 2 : 4; static constexpr bool EARLY_OFF = GATEUP;
    const bf16 *X, *XS, *W, *WS; const int* stok; const LAS int* off; const LAS int* tst; int nmoe, total, G, c; LAS unsigned char* tokl;
    __device__ __forceinline__ bool next(int i, pg8::Unit& u) const {
        const int idx = pg8::xcd_deal(i, G, c, total); if (idx < 0) return false;
        const int mtg = idx / NPN; u.pn = idx % NPN;
        if (mtg >= nmoe) { u.e = 256; u.pm = mtg - nmoe; u.base = (GATEUP ? NASSIGN : 0) + u.pm * 256; u.cnt = 256; }
        else { int lo_ = 0, hi_ = 256; while (hi_ - lo_ > 1) { const int mid = (lo_ + hi_) >> 1; if (tst[mid] <= mtg) lo_ = mid; else hi_ = mid; }
            u.e = lo_; u.pm = mtg - tst[lo_]; u.base = off[lo_] + u.pm * 256; u.cnt = off[lo_ + 1] - u.base; }
        u.e = __builtin_amdgcn_readfirstlane(u.e); u.pm = __builtin_amdgcn_readfirstlane(u.pm); u.pn = __builtin_amdgcn_readfirstlane(u.pn);
        u.base = __builtin_amdgcn_readfirstlane(u.base); u.cnt = __builtin_amdgcn_readfirstlane(u.cnt);
        return true;
    }
    __device__ __forceinline__ const char* a_base(const pg8::Unit& u) const { return (const char*)((!GATEUP && u.e == 256) ? XS : X); }
    __device__ __forceinline__ void a_pre(const pg8::Unit& u, int tid, unsigned (&vr)[4]) const {
        asm volatile("" : "+v"(tid)); int Ra[2], Ca[2]; pg8::stage_rc(tid * 16, Ra[0], Ca[0]); pg8::stage_rc(tid * 16 + 8192, Ra[1], Ca[1]);
        if constexpr (GATEUP) { const int* sp = stok + u.base; const int cm = u.cnt - 1;
            const int wv = __builtin_amdgcn_readfirstlane(tid >> 6);
#pragma unroll
            for (int h = 0; h < 2; ++h)
#pragma unroll
                for (int i = 0; i < 2; ++i) { const int r = h * 128 + Ra[i];
                    __builtin_amdgcn_global_load_lds((const unsigned*)(sp + (r < cm ? r : cm)), (LAS unsigned*)(tokl + wv * 1024 + (h * 2 + i) * 256), 4, 0, 0); vr[h * 2 + i] = 0u; } }
        else {
#pragma unroll
            for (int h = 0; h < 2; ++h)
#pragma unroll
                for (int i = 0; i < 2; ++i) vr[h * 2 + i] = (unsigned)(u.base + h * 128 + Ra[i]); }
    }
    __device__ __forceinline__ void a_fin(const pg8::Unit& u, int tid, int K_, const unsigned (&vr)[4], unsigned (&vo)[4]) const {
        asm volatile("" : "+v"(tid)); int Ra[2], Ca[2]; pg8::stage_rc(tid * 16, Ra[0], Ca[0]); pg8::stage_rc(tid * 16 + 8192, Ra[1], Ca[1]);
#pragma unroll
        for (int h = 0; h < 2; ++h)
#pragma unroll
            for (int i = 0; i < 2; ++i) { unsigned rv;
                if constexpr (GATEUP) rv = *(const LAS unsigned*)(tokl + (tid >> 6) * 1024 + (h * 2 + i) * 256 + (tid & 63) * 4); else rv = vr[h * 2 + i];
                vo[h * 2 + i] = (rv * (unsigned)K_ + (unsigned)Ca[i]) * 2u; }
    }
    __device__ __forceinline__ void a_off(const pg8::Unit& u, int tid, int K_, unsigned (&vo)[4]) const { unsigned vr[4]; a_pre(u, tid, vr); if constexpr (GATEUP) asm volatile("s_waitcnt vmcnt(0)" ::: "memory"); a_fin(u, tid, K_, vr, vo); }
    __device__ __forceinline__ const char* b_base(const pg8::Unit& u) const {
        if (GATEUP) return (const char*)((u.e == 256 ? WS : W + (size_t)u.e * 512 * 1024) + (size_t)u.pn * 128 * 1024);
        else return (const char*)((u.e == 256 ? WS : W + (size_t)u.e * 1024 * 256) + (size_t)u.pn * 256 * 256);
    }
    __device__ __forceinline__ size_t b_hstep(int K_) const { return GATEUP ? (size_t)256 * K_ * 2 : (size_t)128 * K_ * 2; }
};
struct EpiGateUp {
    static constexpr bool PERM = true;
    bf16 *H, *HS;
    __device__ __forceinline__ void operator()(const f32x4 (&acc)[2][2][4][2], const pg8::Unit& u, int wr, int wc, int fr, int fq) const {
        int r0 = wr * 64 + fr; asm volatile("" : "+v"(r0));
        bf16* bp = H + (size_t)u.base * DE + u.pn * 128 + wc * 32 + 8 * fq;
#pragma unroll
        for (int ai = 0; ai < 2; ++ai)
#pragma unroll
            for (int m = 0; m < 4; ++m) { const int r = ai * 128 + m * 16 + r0;
                if (r < u.cnt) { float hv[8];
#pragma unroll
                    for (int n = 0; n < 2; ++n)
#pragma unroll
                        for (int j = 0; j < 4; ++j) { const float g = acc[ai][0][m][n][j], up = acc[ai][1][m][n][j]; hv[n * 4 + j] = g * sigmoidf_(g) * up; }
                    v4u w; w.x = cvtpk(hv[0], hv[1]); w.y = cvtpk(hv[2], hv[3]); w.z = cvtpk(hv[4], hv[5]); w.w = cvtpk(hv[6], hv[7]);
                    *(v4u*)(bp + (size_t)r * DE) = w; } }
    }
};
struct EpiDown {
    static constexpr bool PERM = true;
    bf16 *Y, *YS; const float* sgate;
    __device__ __forceinline__ void operator()(const f32x4 (&acc)[2][2][4][2], const pg8::Unit& u, int wr, int wc, int fr, int fq) const {
        int r0 = wr * 64 + fr; asm volatile("" : "+v"(r0));
        bf16* bp = (u.e == 256 ? YS : Y) + (size_t)u.base * D + u.pn * 256 + wc * 32 + 8 * fq;
#pragma unroll
        for (int ai = 0; ai < 2; ++ai)
#pragma unroll
            for (int m = 0; m < 4; ++m) { const int r = ai * 128 + m * 16 + r0;
                if (r < u.cnt) { const float gt = (u.e == 256) ? 1.0f : sgate[u.base + r];
#pragma unroll
                    for (int bj = 0; bj < 2; ++bj) { const f32x4 v0 = acc[ai][bj][m][0] * gt, v1 = acc[ai][bj][m][1] * gt;
                        v4u w; w.x = cvtpk(v0[0], v0[1]); w.y = cvtpk(v0[2], v0[3]); w.z = cvtpk(v1[0], v1[1]); w.w = cvtpk(v1[2], v1[3]);
                        *(v4u*)(bp + (size_t)r * D + bj * 128) = w; } } }
    }
};

__device__ __forceinline__ void p0_transpose_item(const float* W, int K, int N, bf16* WT, int row_off, LAS unsigned char* scr, int item, int lane) {
    const int nblk = N / 64, kb = item / nblk, nb = item % nblk, k0 = 64 * kb, n0 = 64 * nb;
    const float* src = W + (size_t)k0 * N + n0 + lane;
    float v[64];
#pragma unroll
    for (int j = 0; j < 64; ++j) v[j] = __builtin_nontemporal_load(src + (size_t)j * N);
#pragma unroll
    for (int g = 0; g < 8; ++g) { v4u o; o.x = pk2(v[8 * g], v[8 * g + 1]); o.y = pk2(v[8 * g + 2], v[8 * g + 3]); o.z = pk2(v[8 * g + 4], v[8 * g + 5]); o.w = pk2(v[8 * g + 6], v[8 * g + 7]);
        *(LAS v4u*)(scr + lane * 144 + g * 16) = o; }
    LDS_WAIT(); asm volatile("" ::: "memory");
    bf16* dst = WT + (size_t)(row_off + n0 + (lane >> 3)) * K + k0 + (lane & 7) * 8;
#pragma unroll
    for (int j = 0; j < 8; ++j) { const v4u o = *(const LAS v4u*)(scr + (8 * j + (lane >> 3)) * 144 + (lane & 7) * 16); *(v4u*)(dst + (size_t)(8 * j) * K) = o; }
    LDS_WAIT(); asm volatile("" ::: "memory");
}

__device__ __forceinline__ void sincos_d(double x, float& s, float& c) {
    const double k = __builtin_rint(x * 0.63661977236758134308);
    double r = __builtin_fma(-k, 1.57079632679489655800e+00, x); r = __builtin_fma(-k, 6.12323399573676603587e-17, r);
    const int q = ((int)k) & 3;
    const float rf = (float)r, z = rf * rf;
    const float sp = rf + rf * z * (-1.6666667163e-01f + z * (8.3333337680e-03f + z * (-1.9841270114e-04f + z * 2.7557314297e-06f)));
    const float cp = 1.0f - 0.5f * z + z * z * (4.1666667908e-02f + z * (-1.3888889225e-03f + z * (2.4801587642e-05f + z * -2.7557314297e-07f)));
    s = (q == 0) ? sp : (q == 1) ? cp : (q == 2) ? -sp : -cp;
    c = (q == 0) ? cp : (q == 1) ? -sp : (q == 2) ? -cp : sp;
}

__device__ __forceinline__ void p0_ssm_group(int g, int tid, LAS unsigned char* lds, const float* log_dt, const float* a_re, const float* a_im,
                                             const float* b_re, const float* b_im, const float* c_re, const float* c_im, bf16* W1, bf16* W2, float* LAM16) {
    LAS float* lp_re = (LAS float*)lds;
    LAS float* lp_im = lp_re + 17 * 64;
    LAS float* bb_re = lp_im + 17 * 64;
    LAS float* bb_im = bb_re + 1024;
    LAS float* cc_re = bb_im + 1024;
    LAS float* cc_im = cc_re + 1024;
    LAS float* ktab = cc_im + 1024;
    __syncthreads();
    const float dt = __expf(log_dt[g]);
    if (tid < 64) {
        const int p = tid; const float a = a_re[g * 64 + p], w = a_im[g * 64 + p];
        for (int tau = 0; tau <= 16; ++tau) { float s, c; sincos_d((double)w * (double)dt * (double)tau, s, c); const float mg = __expf(a * dt * (float)tau);
            lp_re[tau * 64 + p] = mg * c; lp_im[tau * 64 + p] = mg * s; }
        const float lr = lp_re[64 + p], li = lp_im[64 + p];
        const float den = a * a + w * w;
        const float cr = ((lr - 1.0f) * a + li * w) / den, ci = (li * a - (lr - 1.0f) * w) / den;
        for (int h = 0; h < 16; ++h) { const float br = b_re[(g * 64 + p) * 16 + h], bi = b_im[(g * 64 + p) * 16 + h];
            bb_re[p * 16 + h] = cr * br - ci * bi; bb_im[p * 16 + h] = cr * bi + ci * br; }
        LAM16[(g * 64 + p) * 2 + 0] = lp_re[16 * 64 + p]; LAM16[(g * 64 + p) * 2 + 1] = lp_im[16 * 64 + p];
    }
    for (int i = tid; i < 1024; i += NTHR) { cc_re[i] = c_re[g * 1024 + i]; cc_im[i] = c_im[g * 1024 + i]; }
    __syncthreads();
    for (int e = tid; e < 4096; e += NTHR) { const int tau = e >> 8, h = (e >> 4) & 15, hp = e & 15; float acc = 0.f;
        for (int p = 0; p < 64; ++p) { const float lr = lp_re[tau * 64 + p], li = lp_im[tau * 64 + p], br = bb_re[p * 16 + hp], bi = bb_im[p * 16 + hp];
            const float zr = lr * br - li * bi, zi = lr * bi + li * br;
            acc += cc_re[h * 64 + p] * zr - cc_im[h * 64 + p] * zi; }
        ktab[e] = acc; }
    __syncthreads();
    bf16* w1 = W1 + (size_t)g * 128 * 256;
    for (int e = tid; e < 128 * 256; e += NTHR) { const int n = e >> 8, k = e & 255, p = n & 63, j = k >> 4, hp = k & 15, tau = 15 - j;
        const float lr = lp_re[tau * 64 + p], li = lp_im[tau * 64 + p], br = bb_re[p * 16 + hp], bi = bb_im[p * 16 + hp];
        const float v = (n < 64) ? (lr * br - li * bi) : (lr * bi + li * br);
        w1[e] = (bf16)f2bf(v); }
    bf16* w2 = W2 + (size_t)g * 256 * 384;
    for (int e = tid; e < 256 * 384; e += NTHR) { const int n = e / 384, k = e % 384, i = n >> 4, h = n & 15; float v;
        if (k < 256) { const int j = k >> 4, hp = k & 15; v = (j <= i) ? ktab[((i - j) << 8) + (h << 4) + hp] : 0.f; }
        else { const int q = k - 256, p = q & 63, tau = i + 1; const float lr = lp_re[tau * 64 + p], li = lp_im[tau * 64 + p], cr = cc_re[h * 64 + p], ci = cc_im[h * 64 + p];
            v = (q < 64) ? (cr * lr - ci * li) : -(cr * li + ci * lr); }
        w2[e] = (bf16)f2bf(v); }
    __syncthreads();
}

struct Args { const float* in[38]; float* out; unsigned char* ws; int ph_lo, ph_hi; };

constexpr int N_PHASES = 19;

__global__ void __launch_bounds__(NTHR, 2) fwd(Args args) {
    extern __shared__ __attribute__((aligned(16))) unsigned char lds_raw[];
    LAS unsigned char* lds = (LAS unsigned char*)lds_raw;
    volatile LAS unsigned* MISC = (volatile LAS unsigned*)(lds + MISC_OFF);
    const int tid = threadIdx.x, lane = tid & 63, wave = __builtin_amdgcn_readfirstlane(tid >> 6);
    const int G = gridDim.x; const int bx = blockIdx.x; const int vcu = (G % 8 == 0) ? (bx % 8) * (G / 8) + bx / 8 : bx;
    const int gw = vcu * NWAVES + wave, ngw = G * NWAVES;
    const int gtid = vcu * NTHR + tid, ngt = G * NTHR;
    const int fr = lane & 15, fq = lane >> 4;
    unsigned char* ws = args.ws;
    unsigned* ctl = (unsigned*)(ws + WS_CTL);
    for (int u = tid; u < (LDS_BYTES - 131072) / 4; u += NTHR) ((LAS unsigned*)(lds + 131072))[u] = 0u;
    __syncthreads();
#if MK_SPLIT
#define GRID_BAR() do { } while (0)
#else
    XcdBarrier bar = xcd_barrier_post(ctl + CW_BAR, MISC + 8);
#define GRID_BAR() xcd_barrier(bar)
#endif
    const int lo = args.ph_lo, hi = args.ph_hi;
#ifndef PROBE_MASK
#define PROBE_MASK 0u
#endif
#define NREP(k) (((PROBE_MASK >> (k)) & 1u) ? 2 : 1)
#ifndef PROBE_DUP_P0
#define PROBE_DUP_P0 0
#endif
#ifndef ONLY_PHASE
#define ONLY_PHASE -1
#endif
#define IN(k) ((ONLY_PHASE < 0 || ONLY_PHASE == (k)) && lo <= (k) && (k) < hi)
#define BOTH(k) (IN(k) && IN((k) + 1))

    const float* x = args.in[0];
    bf16* XB = (bf16*)(ws + WS_XB); bf16* CV = (bf16*)(ws + WS_CV); bf16* AS = (bf16*)(ws + WS_AS); float* SEND = (float*)(ws + WS_SEND);
    bf16* Z = (bf16*)(ws + WS_Z); float* ZG = (float*)(ws + WS_ZG); bf16* MERGED = (bf16*)(ws + WS_MERGED); float* Y1 = (float*)(ws + WS_Y1);
    float* X1 = (float*)(ws + WS_X1); bf16* X1B = (bf16*)(ws + WS_X1B); bf16* Q = (bf16*)(ws + WS_Q); bf16* O = (bf16*)(ws + WS_O);
    float* X2 = (float*)(ws + WS_X2); bf16* X2B = (bf16*)(ws + WS_X2B); float* LOGITS = (float*)(ws + WS_LOGITS);
    bf16* H = (bf16*)(ws + WS_H); bf16* HS = (bf16*)(ws + WS_HS); bf16* Y = (bf16*)(ws + WS_Y); bf16* YS = (bf16*)(ws + WS_YS);
    bf16* W_IN_T = (bf16*)(ws + WS_W_IN_T); bf16* W_GLU_T = (bf16*)(ws + WS_W_GLU_T); bf16* W_OUT_T = (bf16*)(ws + WS_W_OUT_T);
    bf16* WQ_T = (bf16*)(ws + WS_WQ_T); bf16* WKV_T = (bf16*)(ws + WS_WKV_T); bf16* WO_T = (bf16*)(ws + WS_WO_T); bf16* WR_T = (bf16*)(ws + WS_WR_T);
    bf16* SSM_W1 = (bf16*)(ws + WS_SSM_W1); bf16* SSM_W2 = (bf16*)(ws + WS_SSM_W2); float* LAM16 = (float*)(ws + WS_LAM16);
    bf16* SH_GU_T = (bf16*)(ws + WS_SH_GU_T); bf16* SH_D_T = (bf16*)(ws + WS_SH_D_T);
    bf16* MEMB = (bf16*)(ws + WS_MEMB); bf16* KB = (bf16*)(ws + WS_KB); bf16* VT = (bf16*)(ws + WS_VT);
    bf16* WGU_T = (bf16*)(ws + WS_WGU_T); bf16* WD_T = (bf16*)(ws + WS_WD_T);
    int* TOPE = (int*)(ws + WS_TOPE); int* TOPP = (int*)(ws + WS_TOPP); float* GATE = (float*)(ws + WS_GATE); int* SLOT = (int*)(ws + WS_SLOT);
    int* STOK = (int*)(ws + WS_STOK); float* SGATE = (float*)(ws + WS_SGATE);
    unsigned* CNT = ctl + CW_CNT;

    if (IN(0)) {
        LAS unsigned char* scr = lds + wave * 9216;
        constexpr int I_SMALL = 384 + 64 + 256 * 4 + 256 + 64 * 4;
        for (int rep = 0; rep <= PROBE_DUP_P0; ++rep)
        for (int mi = vcu; mi < NE * 3; mi += G) { const int e = mi / 3, w3 = mi % 3;
            for (int q = wave; q < 64; q += NWAVES) {
                if (w3 == 0) p0_transpose_item(args.in[30] + (size_t)e * D * DE, D, DE, WGU_T + (size_t)e * 512 * D, 0, scr, q, lane);
                else if (w3 == 1) p0_transpose_item(args.in[31] + (size_t)e * D * DE, D, DE, WGU_T + (size_t)e * 512 * D, 256, scr, q, lane);
                else p0_transpose_item(args.in[32] + (size_t)e * DE * D, DE, D, WD_T + (size_t)e * D * DE, 0, scr, q, lane); } }
        for (int it = gw; it < I_SMALL; it += ngw) {
            int r = it;
            if (r < 384) { p0_transpose_item(args.in[2], D, 1536, W_IN_T, 0, scr, r, lane); continue; } r -= 384;
            if (r < 64) { p0_transpose_item(args.in[15], 512, 512, W_GLU_T, 0, scr, r, lane); continue; } r -= 64;
            if (r < 256) { p0_transpose_item(args.in[19], D, D, W_OUT_T, 0, scr, r, lane); continue; } r -= 256;
            if (r < 256) { p0_transpose_item(args.in[22], D, D, WQ_T, 0, scr, r, lane); continue; } r -= 256;
            if (r < 256) { p0_transpose_item(args.in[23], D, D, WKV_T, 0, scr, r, lane); continue; } r -= 256;
            if (r < 256) { p0_transpose_item(args.in[24], D, D, WKV_T, 1024, scr, r, lane); continue; } r -= 256;
            if (r < 256) { p0_transpose_item(args.in[25], D, D, WO_T, 0, scr, r, lane); continue; } r -= 256;
            if (r < 64) { p0_transpose_item(args.in[28], D, 256, WR_T, 0, scr, r, lane); continue; } r -= 64;
            if (r < 64) { p0_transpose_item(args.in[33], D, 256, SH_GU_T, 0, scr, r, lane); continue; } r -= 64;
            if (r < 64) { p0_transpose_item(args.in[34], D, 256, SH_GU_T, 256, scr, r, lane); continue; } r -= 64;
            p0_transpose_item(args.in[35], 256, D, SH_D_T, 0, scr, r, lane);
        }
        for (size_t i = (size_t)gtid * 8; i < (size_t)T * D; i += (size_t)ngt * 8) { const f32x4 a = *(const f32x4*)(x + i), b = *(const f32x4*)(x + i + 4);
            v4u o; o.x = pk2(a[0], a[1]); o.y = pk2(a[2], a[3]); o.z = pk2(b[0], b[1]); o.w = pk2(b[2], b[3]); *(v4u*)(XB + i) = o; }
        for (size_t i = (size_t)gtid * 8; i < (size_t)NB * MEML * D; i += (size_t)ngt * 8) { const f32x4 a = *(const f32x4*)(args.in[1] + i), b = *(const f32x4*)(args.in[1] + i + 4);
            v4u o; o.x = pk2(a[0], a[1]); o.y = pk2(a[2], a[3]); o.z = pk2(b[0], b[1]); o.w = pk2(b[2], b[3]); *(v4u*)(MEMB + i) = o; }
        __syncthreads();
        for (int g = vcu; g < NG; g += G)
            p0_ssm_group(g, tid, lds, args.in[7], args.in[8], args.in[9], args.in[10], args.in[11], args.in[12], args.in[13], SSM_W1, SSM_W2, LAM16);
        if (BOTH(0)) GRID_BAR();
    }

    if (IN(1)) {
        ProjSched S{(const char*)XB, (const char*)W_IN_T, (const char*)MEMB, (const char*)WKV_T, G, bx};
        EpiProj E{CV, AS, KB, VT};
        for (int rep = 0; rep < NREP(1); ++rep) pg8::gemm_phase<EpiProj, ProjSched, true>(lds, D, S, E);
        if (BOTH(1)) GRID_BAR();
    }

    if (IN(2)) {
        constexpr int TPG = (NCH / 64) * 2, TILES = NG * TPG;
        for (int t = gw; t < TILES; t += ngw) {
            const int g = t / TPG, q = t % TPG, m0 = (q >> 1) * 64, n0 = (q & 1) * 64;
            const bf16* ar[4]; const bf16* br[4];
#pragma unroll
            for (int i = 0; i < 4; ++i) { ar[i] = AS + ((size_t)(g * NCH + m0 + 16 * i + fr)) * 384 + fq * 8; br[i] = SSM_W1 + ((size_t)(g * 128 + n0 + 16 * i + fr)) * 256 + fq * 8; }
            f32x4 acc[4][4]; zero_acc(acc);
            wave_mma<4, 4>(ar, br, 256, acc);
#pragma unroll
            for (int i = 0; i < 4; ++i)
#pragma unroll
                for (int j = 0; j < 4; ++j) *(f32x4*)(SEND + ((size_t)(g * NCH + m0 + 16 * i + fr)) * 128 + n0 + 16 * j + 4 * fq) = acc[i][j];
        }
        if (BOTH(2)) GRID_BAR();
    }

    if (IN(3)) {
        constexpr int NSCAN = 16;
        if (vcu < NSCAN && G > NSCAN) {
            const int g = gw >> 2, b = gw & 3, p = lane;
            const float lr = LAM16[(g * 64 + p) * 2], li = LAM16[(g * 64 + p) * 2 + 1];
            float sr = 0.f, si = 0.f;
            const float* sp = SEND + ((size_t)(g * NCH + b * 256)) * 128 + p; bf16* ap = AS + ((size_t)(g * NCH + b * 256)) * 384 + 256 + p;
            float er[16], ei[16], nr_[16], ni_[16];
#pragma unroll
            for (int q = 0; q < 16; ++q) { er[q] = sp[(size_t)q * 128]; ei[q] = sp[(size_t)q * 128 + 64]; }
            for (int c0 = 0; c0 < SEQ / LC; c0 += 16) {
                const int cn = (c0 + 16 < SEQ / LC) ? c0 + 16 : c0;
#pragma unroll
                for (int q = 0; q < 16; ++q) { nr_[q] = sp[(size_t)(cn + q) * 128]; ni_[q] = sp[(size_t)(cn + q) * 128 + 64]; }
#pragma unroll
                for (int q = 0; q < 16; ++q) { ap[(size_t)(c0 + q) * 384] = (bf16)f2bf(sr); ap[(size_t)(c0 + q) * 384 + 64] = (bf16)f2bf(si);
                    const float nr = lr * sr - li * si + er[q], ni = lr * si + li * sr + ei[q]; sr = nr; si = ni; }
#pragma unroll
                for (int q = 0; q < 16; ++q) { er[q] = nr_[q]; ei[q] = ni_[q]; }
            }
        } else {
            const int nconv = (G > NSCAN) ? G - NSCAN : G, ci = (G > NSCAN) ? vcu - NSCAN : vcu;
            const int g_lo = (int)(((long)ci * (T / 8)) / nconv), g_hi = (int)(((long)(ci + 1) * (T / 8)) / nconv);
            LAS float* yl = (LAS float*)lds;
            const int c = tid;
            float wk[CW];
#pragma unroll
            for (int k = 0; k < CW; ++k) wk[k] = args.in[3][k * DC + c];
            const float cb = args.in[4][c];
            float win[38];
#pragma unroll
            for (int k = 0; k < 38; ++k) win[k] = 0.f;
            {
                const int t0 = g_lo * 8;
#pragma unroll
                for (int k = 0; k < 30; ++k) { const int t = t0 - 30 + k; float hv = 0.f;
                    if (t >= 0 && (t >> 12) == (t0 >> 12)) { const size_t o = (size_t)t * 1024 + c; hv = bf2f(CV[o]) * sigmoidf_(bf2f(CV[o + 512])); }
                    win[k] = hv; }
            }
            int rows = 0, row_t0 = g_lo * 8;
            for (int gi = g_lo; gi < g_hi; ++gi) {
                const int t0 = gi * 8;
                if ((t0 & (SEQ - 1)) == 0) {
#pragma unroll
                    for (int k = 0; k < 30; ++k) win[k] = 0.f; }
#pragma unroll
                for (int j = 0; j < 8; ++j) { const size_t o = (size_t)(t0 + j) * 1024 + c; win[30 + j] = bf2f(CV[o]) * sigmoidf_(bf2f(CV[o + 512])); }
#pragma unroll
                for (int j = 0; j < 8; ++j) { float a = cb;
#pragma unroll
                    for (int k = 0; k < CW; ++k) a += wk[k] * win[j + k];
                    yl[(rows + j) * 512 + c] = a; }
#pragma unroll
                for (int k = 0; k < 30; ++k) win[k] = win[k + 8];
                rows += 8;
                if (rows == 40 || gi + 1 == g_hi) {
                    __syncthreads();
                    for (int r = wave; r < rows; r += NWAVES) {
                        float v[8]; float s = 0.f;
#pragma unroll
                        for (int j = 0; j < 8; ++j) { v[j] = yl[r * 512 + lane + 64 * j]; s += v[j]; }
                        const float mean = wave_sum(s) * (1.0f / 512.0f); float s2 = 0.f;
#pragma unroll
                        for (int j = 0; j < 8; ++j) { v[j] -= mean; s2 += v[j] * v[j]; }
                        const float rstd = 1.0f / sqrtf(wave_sum(s2) * (1.0f / 512.0f) + EPS); float s3 = 0.f;
#pragma unroll
                        for (int j = 0; j < 8; ++j) { const int cc = lane + 64 * j; float y = v[j] * rstd * args.in[5][cc] + args.in[6][cc]; y = y * sigmoidf_(y); v[j] = y; s3 += y * y; }
                        const float rr = 1.0f / sqrtf(wave_sum(s3) * (1.0f / 512.0f) + EPS);
#pragma unroll
                        for (int j = 0; j < 8; ++j) { const int cc = lane + 64 * j; MERGED[(size_t)(row_t0 + r) * 1024 + cc] = (bf16)f2bf(v[j] * rr * args.in[17][cc]); }
                    }
                    __syncthreads();
                    row_t0 += rows; rows = 0;
                }
            }
        }
        if (BOTH(3)) GRID_BAR();
    }

    if (IN(4)) {
        constexpr int TPG = (NCH / 64) * 4, TILES = NG * TPG;
        for (int t = gw; t < TILES; t += ngw) {
            const int g = t / TPG, q = t % TPG, m0 = (q >> 2) * 64, n0 = (q & 3) * 64;
            const bf16* ar[4]; const bf16* br[4];
#pragma unroll
            for (int i = 0; i < 4; ++i) { ar[i] = AS + ((size_t)(g * NCH + m0 + 16 * i + fr)) * 384 + fq * 8; br[i] = SSM_W2 + ((size_t)(g * 256 + n0 + 16 * i + fr)) * 384 + fq * 8; }
            f32x4 acc[4][4]; zero_acc(acc);
            wave_mma<4, 4>(ar, br, 384, acc);
#pragma unroll
            for (int i = 0; i < 4; ++i)
#pragma unroll
                for (int j = 0; j < 4; ++j) { const int r = m0 + 16 * i + fr, n = n0 + 16 * j + 4 * fq, ti = n >> 4, h = n & 15;
                    const v2u uu = *(const v2u*)(AS + ((size_t)(g * NCH + r)) * 384 + n);
                    const f32x4 dd = *(const f32x4*)(args.in[14] + g * 16 + h);
                    const float y0 = acc[i][j][0] + dd[0] * bflo(uu.x), y1 = acc[i][j][1] + dd[1] * bfhi(uu.x), y2 = acc[i][j][2] + dd[2] * bflo(uu.y), y3 = acc[i][j][3] + dd[3] * bfhi(uu.y);
                    v2u w; w.x = pk2(gelu_tanh(y0), gelu_tanh(y1)); w.y = pk2(gelu_tanh(y2), gelu_tanh(y3));
                    *(v2u*)(Z + ((size_t)(r * 16 + ti)) * 512 + g * 16 + h) = w; }
        }
        if (BOTH(4)) GRID_BAR();
    }

    if (IN(5)) {
        constexpr int NT = 512 / 64, TILES = (T / 64) * NT;
        for (int t = gw; t < TILES; t += ngw) {
            const int m0 = (t / NT) * 64, n0 = (t % NT) * 64;
            const bf16* ar[4]; const bf16* br[4];
#pragma unroll
            for (int i = 0; i < 4; ++i) { ar[i] = Z + (size_t)(m0 + 16 * i + fr) * 512 + fq * 8; br[i] = W_GLU_T + (size_t)(n0 + 16 * i + fr) * 512 + fq * 8; }
            f32x4 acc[4][4]; zero_acc(acc);
            wave_mma<4, 4>(ar, br, 512, acc);
#pragma unroll
            for (int i = 0; i < 4; ++i)
#pragma unroll
                for (int j = 0; j < 4; ++j) { const int m = m0 + 16 * i + fr, n = n0 + 16 * j + 4 * fq;
                    const v2u zz = *(const v2u*)(Z + (size_t)m * 512 + n); const f32x4 bg = *(const f32x4*)(args.in[16] + n);
                    f32x4 o; o[0] = bflo(zz.x) * sigmoidf_(acc[i][j][0] + bg[0]); o[1] = bfhi(zz.x) * sigmoidf_(acc[i][j][1] + bg[1]);
                    o[2] = bflo(zz.y) * sigmoidf_(acc[i][j][2] + bg[2]); o[3] = bfhi(zz.y) * sigmoidf_(acc[i][j][3] + bg[3]);
                    *(f32x4*)(ZG + (size_t)m * 512 + n) = o; }
        }
        if (BOTH(5)) GRID_BAR();
    }

    if (IN(6)) {
        for (int m = gw; m < T; m += ngw) {
            const f32x4 a = *(const f32x4*)(ZG + (size_t)m * 512 + lane * 4), b = *(const f32x4*)(ZG + (size_t)m * 512 + 256 + lane * 4);
            float s = (a[0] * a[0] + a[1] * a[1]) + (a[2] * a[2] + a[3] * a[3]) + (b[0] * b[0] + b[1] * b[1]) + (b[2] * b[2] + b[3] * b[3]);
            const float rr = 1.0f / sqrtf(wave_sum(s) * (1.0f / 512.0f) + EPS);
            const f32x4 ga = *(const f32x4*)(args.in[18] + lane * 4), gb = *(const f32x4*)(args.in[18] + 256 + lane * 4);
            v2u w; w.x = pk2(a[0] * rr * ga[0], a[1] * rr * ga[1]); w.y = pk2(a[2] * rr * ga[2], a[3] * rr * ga[3]);
            *(v2u*)(MERGED + (size_t)m * 1024 + 512 + lane * 4) = w;
            w.x = pk2(b[0] * rr * gb[0], b[1] * rr * gb[1]); w.y = pk2(b[2] * rr * gb[2], b[3] * rr * gb[3]);
            *(v2u*)(MERGED + (size_t)m * 1024 + 768 + lane * 4) = w;
        }
        if (BOTH(6)) GRID_BAR();
    }

#define GEMM_D_D(Aptr, Btptr, ...) do { \
        constexpr int NT = D / 64, TILES = (T / 64) * NT; \
        for (int t = gw; t < TILES; t += ngw) { \
            const int m0 = (t / NT) * 64, n0 = (t % NT) * 64; \
            const bf16* ar[4]; const bf16* br[4]; \
            _Pragma("unroll") for (int i = 0; i < 4; ++i) { ar[i] = (Aptr) + (size_t)(m0 + 16 * i + fr) * D + fq * 8; br[i] = (Btptr) + (size_t)(n0 + 16 * i + fr) * D + fq * 8; } \
            f32x4 acc[4][4]; zero_acc(acc); \
            wave_mma<4, 4>(ar, br, D, acc); \
            _Pragma("unroll") for (int i = 0; i < 4; ++i) _Pragma("unroll") for (int j = 0; j < 4; ++j) { const int m = m0 + 16 * i + fr, n = n0 + 16 * j + 4 * fq; const f32x4 v = acc[i][j]; __VA_ARGS__ } \
        } } while (0)

#define LN_ROWS(SRC, GAIN, BIAS, DSTF, DSTB) do { \
        for (int m = gw; m < T; m += ngw) { \
            f32x4 v[4]; float s = 0.f; \
            _Pragma("unroll") for (int j = 0; j < 4; ++j) { v[j] = *(const f32x4*)((SRC) + (size_t)m * D + j * 256 + lane * 4); s += (v[j][0] + v[j][1]) + (v[j][2] + v[j][3]); } \
            const float mean = wave_sum(s) * (1.0f / D); float s2 = 0.f; \
            _Pragma("unroll") for (int j = 0; j < 4; ++j) { v[j] = v[j] - mean; s2 += (v[j][0] * v[j][0] + v[j][1] * v[j][1]) + (v[j][2] * v[j][2] + v[j][3] * v[j][3]); } \
            const float rstd = 1.0f / sqrtf(wave_sum(s2) * (1.0f / D) + EPS); \
            _Pragma("unroll") for (int j = 0; j < 4; ++j) { const f32x4 gg = *(const f32x4*)((GAIN) + j * 256 + lane * 4), bb = *(const f32x4*)((BIAS) + j * 256 + lane * 4); \
                const f32x4 o = v[j] * rstd * gg + bb; *(f32x4*)((DSTF) + (size_t)m * D + j * 256 + lane * 4) = o; \
                if ((DSTB) != nullptr) { v2u w; w.x = pk2(o[0], o[1]); w.y = pk2(o[2], o[3]); *(v2u*)((DSTB) + (size_t)m * D + j * 256 + lane * 4) = w; } } \
        } } while (0)

    if (IN(7)) {
        pg8::DenseSched S; S.init(MERGED, W_OUT_T, T, D, D, G, bx);
        EpiResF32 E{x, Y1};
        pg8::gemm_phase<EpiResF32, pg8::DenseSched, false>(lds, D, S, E);
        if (BOTH(7)) GRID_BAR();
    }
    if (IN(8)) {
        LN_ROWS(Y1, args.in[20], args.in[21], X1, X1B);
        if (BOTH(8)) GRID_BAR();
    }
    if (IN(9)) {
        pg8::DenseSched S; S.init(X1B, WQ_T, T, D, D, G, bx);
        EpiBf16S E{Q, 0.0625f};
        pg8::gemm_phase<EpiBf16S, pg8::DenseSched, false>(lds, D, S, E);
        if (BOTH(9)) GRID_BAR();
    }
    if (IN(10)) {
        for (int rep = 0; rep < NREP(10); ++rep)
        for (int u = vcu; u < NB * NXH * (SEQ / 256); u += G) {
            const int bh = u >> 4, qb = u & 15, b = bh >> 2, h = bh & 3;
            int tl = tid; asm volatile("" : "+v"(tl));
            const int lfr = tl & 15, lfq = (tl >> 4) & 3;
            __syncthreads();
#pragma unroll
            for (int hb = 0; hb < 2; ++hb) { v4u tmp[8];
#pragma unroll
                for (int it = 0; it < 8; ++it) { const int idx = (hb * 8 + it) * NTHR + tl, kap = idx >> 5, c = idx & 31; tmp[it] = *(const v4u*)(KB + (size_t)(b * MEML + kap) * D + h * XHD + c * 8); }
#pragma unroll
                for (int it = 0; it < 8; ++it) { const int idx = (hb * 8 + it) * NTHR + tl, kap = idx >> 5, c = idx & 31;
                    const int rho = (kap & ~31) | (((kap >> 2) & 1) << 4) | (((kap >> 3) & 3) << 2) | (kap & 3);
                    *(LAS v4u*)(lds + rho * 512 + ((c ^ (rho & 15)) << 4)) = tmp[it]; } }
            __syncthreads();
            bf16x8 pf[2][8];
#pragma unroll
            for (int i = 0; i < 2; ++i) {
                bf16x8 qf[8];
                const bf16* qrow = Q + (size_t)(b * SEQ + qb * 256 + wave * 32 + i * 16 + lfr) * D + h * XHD + lfq * 8;
#pragma unroll
                for (int ks = 0; ks < 8; ++ks) qf[ks] = *(const bf16x8*)(qrow + ks * 32);
                f32x4 sc[16];
#pragma unroll
                for (int nt = 0; nt < 16; ++nt) { sc[nt] = (f32x4){0.f, 0.f, 0.f, 0.f};
#pragma unroll
                    for (int ks = 0; ks < 8; ++ks) { const bf16x8 kf = *(const LAS bf16x8*)(lds + (nt * 16 + lfr) * 512 + (((ks * 4 + lfq) ^ lfr) << 4));
                        sc[nt] = __builtin_amdgcn_mfma_f32_16x16x32_bf16(kf, qf[ks], sc[nt], 0, 0, 0); } }
                float mx = -3.0e38f;
#pragma unroll
                for (int nt = 0; nt < 16; ++nt) mx = fmaxf(mx, fmaxf(fmaxf(sc[nt][0], sc[nt][1]), fmaxf(sc[nt][2], sc[nt][3])));
                mx = fmaxf(mx, __shfl_xor(mx, 16)); mx = fmaxf(mx, __shfl_xor(mx, 32));
                float sum = 0.f;
#pragma unroll
                for (int nt = 0; nt < 16; ++nt) {
#pragma unroll
                    for (int r = 0; r < 4; ++r) { const float e = __expf(sc[nt][r] - mx); sc[nt][r] = e; sum += e; } }
                sum += __shfl_xor(sum, 16); sum += __shfl_xor(sum, 32);
                const float inv = 1.0f / sum;
#pragma unroll
                for (int ks = 0; ks < 8; ++ks) { v4u w; w.x = cvtpk(sc[2 * ks][0] * inv, sc[2 * ks][1] * inv); w.y = cvtpk(sc[2 * ks][2] * inv, sc[2 * ks][3] * inv);
                    w.z = cvtpk(sc[2 * ks + 1][0] * inv, sc[2 * ks + 1][1] * inv); w.w = cvtpk(sc[2 * ks + 1][2] * inv, sc[2 * ks + 1][3] * inv); pf[i][ks] = __builtin_bit_cast(bf16x8, w); }
                asm volatile("" ::: "memory");
            }
            __syncthreads();
#pragma unroll
            for (int hb = 0; hb < 2; ++hb) { v4u tmp[8];
#pragma unroll
                for (int it = 0; it < 8; ++it) { const int idx = (hb * 8 + it) * NTHR + tl, d = idx >> 5, c = idx & 31; tmp[it] = *(const v4u*)(VT + ((size_t)(b * 1024 + h * XHD + d)) * 256 + c * 8); }
#pragma unroll
                for (int it = 0; it < 8; ++it) { const int idx = (hb * 8 + it) * NTHR + tl, d = idx >> 5, c = idx & 31; *(LAS v4u*)(lds + d * 512 + ((c ^ (d & 15)) << 4)) = tmp[it]; } }
            __syncthreads();
#pragma unroll
            for (int dt = 0; dt < 16; ++dt) { f32x4 o0 = (f32x4){0.f, 0.f, 0.f, 0.f}, o1 = (f32x4){0.f, 0.f, 0.f, 0.f};
#pragma unroll
                for (int ks = 0; ks < 8; ++ks) { const bf16x8 vf = *(const LAS bf16x8*)(lds + (dt * 16 + lfr) * 512 + (((ks * 4 + lfq) ^ lfr) << 4));
                    o0 = __builtin_amdgcn_mfma_f32_16x16x32_bf16(vf, pf[0][ks], o0, 0, 0, 0); o1 = __builtin_amdgcn_mfma_f32_16x16x32_bf16(vf, pf[1][ks], o1, 0, 0, 0); }
                bf16* orow = O + (size_t)(b * SEQ + qb * 256 + wave * 32 + lfr) * D + h * XHD + dt * 16 + 4 * lfq;
                v2u w; w.x = cvtpk(o0[0], o0[1]); w.y = cvtpk(o0[2], o0[3]); *(v2u*)orow = w;
                w.x = cvtpk(o1[0], o1[1]); w.y = cvtpk(o1[2], o1[3]); *(v2u*)(orow + (size_t)16 * D) = w; }
        }
        __syncthreads();
        if (BOTH(10)) GRID_BAR();
    }
    if (IN(11)) {
        pg8::DenseSched S; S.init(O, WO_T, T, D, D, G, bx);
        EpiResF32 E{X1, Y1};
        pg8::gemm_phase<EpiResF32, pg8::DenseSched, false>(lds, D, S, E);
        if (BOTH(11)) GRID_BAR();
    }
    if (IN(12)) {
        LN_ROWS(Y1, args.in[26], args.in[27], X2, X2B);
        if (BOTH(12)) GRID_BAR();
    }
    if (IN(13)) {
        constexpr int NT = NE / 64, TILES = (T / 64) * NT;
        for (int t = gw; t < TILES; t += ngw) {
            const int m0 = (t / NT) * 64, n0 = (t % NT) * 64;
            const bf16* ar[4]; const bf16* br[4];
#pragma unroll
            for (int i = 0; i < 4; ++i) { ar[i] = X2B + (size_t)(m0 + 16 * i + fr) * D + fq * 8; br[i] = WR_T + (size_t)(n0 + 16 * i + fr) * D + fq * 8; }
            f32x4 acc[4][4]; zero_acc(acc);
            wave_mma<4, 4>(ar, br, D, acc);
#pragma unroll
            for (int i = 0; i < 4; ++i)
#pragma unroll
                for (int j = 0; j < 4; ++j) *(f32x4*)(LOGITS + (size_t)(m0 + 16 * i + fr) * NE + n0 + 16 * j + 4 * fq) = acc[i][j];
        }
        if (BOTH(13)) GRID_BAR();
    }
    if (IN(14)) {
        const f32x4 rb = *(const f32x4*)(args.in[29] + lane * 4);
        for (int m = gw; m < T; m += ngw) {
            const f32x4 lg = *(const f32x4*)(LOGITS + (size_t)m * NE + lane * 4);
            float sc[4], bs[4];
#pragma unroll
            for (int r = 0; r < 4; ++r) { sc[r] = sigmoidf_(lg[r]); bs[r] = sc[r] + rb[r]; }
            float m1 = fmaxf(bs[0], bs[1]), m2 = fminf(bs[0], bs[1]);
            { const float a = bs[2]; const float n1 = fmaxf(m1, a); m2 = fmaxf(m2, fminf(m1, a)); m1 = n1; }
            { const float a = bs[3]; const float n1 = fmaxf(m1, a); m2 = fmaxf(m2, fminf(m1, a)); m1 = n1; }
#pragma unroll
            for (int o = 1; o < 8; o <<= 1) { const float o1 = __shfl_xor(m1, o), o2 = __shfl_xor(m2, o); const float n1 = fmaxf(m1, o1); m2 = fmaxf(fminf(m1, o1), fmaxf(m2, o2)); m1 = n1; }
            const float gs = m1 + m2; const int myg = lane >> 3;
            int rank = 0;
#pragma unroll
            for (int g2 = 0; g2 < 8; ++g2) { const float og = __shfl(gs, g2 * 8); rank += (og > gs || (og == gs && g2 < myg)) ? 1 : 0; }
            const bool sel = rank < TKG;
            float mv[4];
#pragma unroll
            for (int r = 0; r < 4; ++r) mv[r] = sel ? bs[r] : -3.0e38f;
            int my_e = 0; float my_sc = 0.f; float gsum = 0.f;
#pragma unroll
            for (int k = 0; k < TOPK; ++k) {
                float bv = mv[0]; int bi = 0;
#pragma unroll
                for (int r = 1; r < 4; ++r) if (mv[r] > bv) { bv = mv[r]; bi = r; }
                int be = lane * 4 + bi;
#pragma unroll
                for (int o = 1; o < 64; o <<= 1) { const float ov = __shfl_xor(bv, o); const int oe = __shfl_xor(be, o); if (ov > bv || (ov == bv && oe < be)) { bv = ov; be = oe; } }
                const int wl = be >> 2, wr_ = be & 3;
                float wsc = (wr_ == 0) ? sc[0] : (wr_ == 1) ? sc[1] : (wr_ == 2) ? sc[2] : sc[3];
                wsc = __shfl(wsc, wl);
                if (lane == wl) {
#pragma unroll
                    for (int r = 0; r < 4; ++r) if (r == wr_) mv[r] = -3.0e38f; }
                gsum += wsc;
                if (lane == k) { my_e = be; my_sc = wsc; }
            }
            if (lane < TOPK) { const unsigned pos = __hip_atomic_fetch_add(CNT + my_e, 1u, RLX_AGENT);
                TOPE[m * 8 + lane] = my_e; TOPP[m * 8 + lane] = (int)pos; GATE[m * 8 + lane] = ROUTED_SCALE * my_sc / gsum; }
        }
        if (BOTH(14)) GRID_BAR();
    }
#define MOE_OFFSETS() LAS int* off = (LAS int*)(lds + 132096); LAS int* tst = off + 260; \
        __syncthreads(); \
        if (tid < 64) { int c4[4]; int s = 0, s2 = 0; \
            _Pragma("unroll") for (int r = 0; r < 4; ++r) { c4[r] = (int)__hip_atomic_load(CNT + tid * 4 + r, RLX_AGENT); s += c4[r]; s2 += (c4[r] + 255) >> 8; } \
            int ps = s, ps2 = s2; \
            _Pragma("unroll") for (int o = 1; o < 64; o <<= 1) { const int a = __shfl_up(ps, o), a2 = __shfl_up(ps2, o); if (lane >= o) { ps += a; ps2 += a2; } } \
            int e0 = ps - s, t0 = ps2 - s2; \
            _Pragma("unroll") for (int r = 0; r < 4; ++r) { off[tid * 4 + r] = e0; tst[tid * 4 + r] = t0; e0 += c4[r]; t0 += (c4[r] + 255) >> 8; } \
            if (tid == 63) { off[256] = e0; tst[256] = t0; } } \
        __syncthreads();

    if (IN(15)) {
        MOE_OFFSETS();
        for (int a = gtid; a < NASSIGN; a += ngt) { const int e = TOPE[a], sl = off[e] + TOPP[a]; SLOT[a] = sl; STOK[sl] = a >> 3; SGATE[sl] = GATE[a]; }
        for (int t = gtid; t < T; t += ngt) STOK[NASSIGN + t] = t;
        if (BOTH(15)) GRID_BAR();
    }
    if (IN(16)) {
        MOE_OFFSETS();
        const int nmoe = tst[256];
        MoeSched<true> S{X2B, X2B, WGU_T, SH_GU_T, STOK, off, tst, nmoe, (nmoe + T / 256) * 2, G, bx, lds + 135168};
        EpiGateUp E{H, HS};
        for (int rep = 0; rep < NREP(16); ++rep) pg8::gemm_phase<EpiGateUp, MoeSched<true>, true>(lds, D, S, E);
        if (BOTH(16)) GRID_BAR();
    }
    if (IN(17)) {
        MOE_OFFSETS();
        const int nmoe = tst[256];
        MoeSched<false> S{H, HS, WD_T, SH_D_T, STOK, off, tst, nmoe, (nmoe + T / 256) * 4, G, bx, lds + 135168};
        EpiDown E{Y, YS, SGATE};
        for (int rep = 0; rep < NREP(17); ++rep) pg8::gemm_phase<EpiDown, MoeSched<false>, true>(lds, DE, S, E);
        if (BOTH(17)) GRID_BAR();
    }
    if (IN(18)) {
        for (int rep = 0; rep < NREP(18); ++rep)
        for (int m = gw; m < T; m += ngw) {
            f32x4 v[4];
#pragma unroll
            for (int j = 0; j < 4; ++j) { v[j] = *(const f32x4*)(X2 + (size_t)m * D + j * 256 + lane * 4) * ALPHA;
                const v2u ys = *(const v2u*)(YS + (size_t)m * D + j * 256 + lane * 4); v[j][0] += bflo(ys.x); v[j][1] += bfhi(ys.x); v[j][2] += bflo(ys.y); v[j][3] += bfhi(ys.y); }
#pragma unroll
            for (int k = 0; k < TOPK; ++k) { const int sl = SLOT[m * 8 + k];
#pragma unroll
                for (int j = 0; j < 4; ++j) { const v2u yy = *(const v2u*)(Y + (size_t)sl * D + j * 256 + lane * 4); v[j][0] += bflo(yy.x); v[j][1] += bfhi(yy.x); v[j][2] += bflo(yy.y); v[j][3] += bfhi(yy.y); } }
            float s = 0.f;
#pragma unroll
            for (int j = 0; j < 4; ++j) s += (v[j][0] + v[j][1]) + (v[j][2] + v[j][3]);
            const float mean = wave_sum(s) * (1.0f / D); float s2 = 0.f;
#pragma unroll
            for (int j = 0; j < 4; ++j) { v[j] = v[j] - mean; s2 += (v[j][0] * v[j][0] + v[j][1] * v[j][1]) + (v[j][2] * v[j][2] + v[j][3] * v[j][3]); }
            const float rstd = 1.0f / sqrtf(wave_sum(s2) * (1.0f / D) + EPS);
#pragma unroll
            for (int j = 0; j < 4; ++j) { const f32x4 gg = *(const f32x4*)(args.in[36] + j * 256 + lane * 4), bb = *(const f32x4*)(args.in[37] + j * 256 + lane * 4);
                *(f32x4*)(args.out + (size_t)m * D + j * 256 + lane * 4) = v[j] * rstd * gg + bb; }
        }
    }
#undef IN
#undef BOTH
}

extern "C" void kernel_launch(void* const* d_in, const int* in_sizes, int n_in, void* d_out, int out_size, void* d_ws, size_t ws_size, hipStream_t stream) {
    static int grid = 0;
    if (grid == 0) {
        if (n_in != 38 || out_size != T * D || ws_size < WS_END) { fprintf(stderr, "kernel_launch: unexpected shapes (n_in %d, out %d, ws %zu)\n", n_in, out_size, ws_size); grid = -1; return; }
        int dev = 0, cus = 0, per_cu = 0;
        if (hipGetDevice(&dev) != hipSuccess || hipDeviceGetAttribute(&cus, hipDeviceAttributeMultiprocessorCount, dev) != hipSuccess) { grid = -1; return; }
        if (hipFuncSetAttribute((const void*)fwd, hipFuncAttributeMaxDynamicSharedMemorySize, LDS_BYTES) != hipSuccess) { fprintf(stderr, "kernel_launch: hipFuncSetAttribute failed\n"); grid = -1; return; }
        if (hipOccupancyMaxActiveBlocksPerMultiprocessor(&per_cu, (const void*)fwd, NTHR, LDS_BYTES) != hipSuccess || per_cu < 1) { fprintf(stderr, "kernel_launch: occupancy query says %d\n", per_cu); }
        (void)hipGetLastError();
        grid = cus;
    }
    if (grid < 0) return;
    (void)hipMemsetAsync((char*)d_ws + WS_CTL, 0, CTL_ZERO_BYTES, stream);
    Args a{};
    for (int i = 0; i < 38; ++i) a.in[i] = (const float*)d_in[i];
    a.out = (float*)d_out; a.ws = (unsigned char*)d_ws;
#if MK_SPLIT
    for (int p = 0; p < N_PHASES; ++p) { a.ph_lo = p; a.ph_hi = p + 1; hipLaunchKernelGGL(fwd, dim3(grid), dim3(NTHR), LDS_BYTES, stream, a); }
#else
    a.ph_lo = 0; a.ph_hi = N_PHASES;
    hipLaunchKernelGGL(fwd, dim3(grid), dim3(NTHR), LDS_BYTES, stream, a);
#endif
}
```

```cpp
#include <hip/hip_runtime.h>
#include <cstdio>
#include <cstdint>

#ifndef MK_SPLIT
#define MK_SPLIT 0
#endif

#define GAS __attribute__((address_space(1)))
#define LAS __attribute__((address_space(3)))
typedef unsigned short bf16;
typedef short bf16x8 __attribute__((ext_vector_type(8)));
typedef float f32x4 __attribute__((ext_vector_type(4)));
typedef unsigned v4u __attribute__((ext_vector_type(4)));
typedef unsigned v2u __attribute__((ext_vector_type(2)));
#define RLX_AGENT __ATOMIC_RELAXED, __HIP_MEMORY_SCOPE_AGENT
#define LDS_WAIT() asm volatile("s_waitcnt lgkmcnt(0)" ::: "memory")

constexpr int NB = 4, SEQ = 4096, T = NB * SEQ, D = 1024;
constexpr int DC = 512, DS = 512, CW = 31, NG = 32, GH = 16, PS = 64;
constexpr int LC = 16, NCH = T / LC;
constexpr int MEML = 256, NXH = 4, XHD = 256;
constexpr int NE = 256, TOPK = 8, NEG = 8, TKG = 4, DE = 256;
constexpr int NASSIGN = T * TOPK;
constexpr float ALPHA = 1.189207115002721f;
constexpr float EPS = 1e-5f;
constexpr float ROUTED_SCALE = 2.5f;
constexpr int NWAVES = 8, NTHR = 512;

constexpr size_t MiB = 1u << 20;
constexpr size_t WS_CTL = 0, CTL_ZERO_BYTES = 1 * MiB;
constexpr size_t WS_W_IN_T = 1 * MiB;
constexpr size_t WS_W_GLU_T = 4 * MiB;
constexpr size_t WS_W_OUT_T = 5 * MiB;
constexpr size_t WS_WQ_T = 7 * MiB;
constexpr size_t WS_WKV_T = 9 * MiB;
constexpr size_t WS_WO_T = 13 * MiB;
constexpr size_t WS_WR_T = 15 * MiB;
constexpr size_t WS_SSM_W1 = 932 * MiB;
constexpr size_t WS_SSM_W2 = 18 * MiB;
constexpr size_t WS_SH_GU_T = 24 * MiB;
constexpr size_t WS_SH_D_T = 25 * MiB;
constexpr size_t WS_LAM16 = 25 * MiB + 512 * 1024;
constexpr size_t WS_MEMB = 26 * MiB;
constexpr size_t WS_KB = 28 * MiB;
constexpr size_t WS_VT = 30 * MiB;
constexpr size_t WS_WGU_T = 32 * MiB;
constexpr size_t WS_WD_T = 288 * MiB;
constexpr size_t WS_X2 = 416 * MiB;
constexpr size_t WS_X2B = 480 * MiB;
constexpr size_t WS_Y = 512 * MiB;
constexpr size_t WS_XB = 512 * MiB;
constexpr size_t WS_CV = 544 * MiB;
constexpr size_t WS_AS = 576 * MiB;
constexpr size_t WS_SEND = 600 * MiB;
constexpr size_t WS_Z = 616 * MiB;
constexpr size_t WS_ZG = 632 * MiB;
constexpr size_t WS_MERGED = 664 * MiB;
constexpr size_t WS_Y1 = 696 * MiB;
constexpr size_t WS_H = 768 * MiB;
constexpr size_t WS_Q = 768 * MiB;
constexpr size_t WS_O = 800 * MiB;
constexpr size_t WS_X1 = 832 * MiB;
constexpr size_t WS_X1B = 896 * MiB;
constexpr size_t WS_YS = 840 * MiB;
constexpr size_t WS_HS = 832 * MiB;
constexpr size_t WS_LOGITS = 872 * MiB;
constexpr size_t WS_TOPE = 928 * MiB;
constexpr size_t WS_TOPP = 928 * MiB + 512 * 1024;
constexpr size_t WS_GATE = 929 * MiB;
constexpr size_t WS_SLOT = 929 * MiB + 512 * 1024;
constexpr size_t WS_STOK = 930 * MiB;
constexpr size_t WS_SGATE = 931 * MiB;
constexpr size_t WS_END = 936 * MiB;
static_assert(WS_HS == WS_H + (size_t)NASSIGN * 256 * 2, "HS follows H");
constexpr int CW_BAR = 4096;
constexpr int CW_CNT = 16384;

constexpr int LDS_BYTES = 147456;
constexpr int MISC_OFF = 131072 + 320;

__device__ __forceinline__ unsigned f2bf(float f) { unsigned u = __builtin_bit_cast(unsigned, f); return (u + 0x7fffu + ((u >> 16) & 1u)) >> 16; }
__device__ __forceinline__ unsigned pk2(float lo, float hi) { return f2bf(lo) | (f2bf(hi) << 16); }
__device__ __forceinline__ float bf2f(unsigned h) { return __builtin_bit_cast(float, h << 16); }
__device__ __forceinline__ float bflo(unsigned w) { return __builtin_bit_cast(float, w << 16); }
__device__ __forceinline__ float bfhi(unsigned w) { return __builtin_bit_cast(float, w & 0xffff0000u); }
typedef float f32x2_t __attribute__((ext_vector_type(2)));
typedef __bf16 bf16x2_t __attribute__((ext_vector_type(2)));
__device__ __forceinline__ unsigned cvtpk(float lo, float hi) { f32x2_t v = {lo, hi}; bf16x2_t b = __builtin_convertvector(v, bf16x2_t); return __builtin_bit_cast(unsigned, b); }
__device__ __forceinline__ float sigmoidf_(float x) { return __builtin_amdgcn_rcpf(1.0f + __expf(-x)); }
__device__ __forceinline__ float wave_sum(float v) {
#pragma unroll
    for (int o = 1; o < 64; o <<= 1) v += __shfl_xor(v, o);
    return v;
}
__device__ __forceinline__ float gelu_tanh(float x) {
    const float u = 0.7978845608028654f * (x + 0.044715f * x * x * x);
    const float t = 1.0f - 2.0f / (1.0f + __expf(2.0f * u));
    return 0.5f * x * (1.0f + t);
}

#define XB_TMO      128
#define XB_XCNT(j)  (256  + 64 * (j))
#define XB_XSUB(j)  (1280 + 64 * (j))
#define XB_XGEN(j)  (2304 + 64 * (j))
#define XB_TOP      3328
#define XB_TOPGEN   3392
#define XCD_BAR_WORDS 3456
#define XB_SPIN_CAP (1u << 20)

__device__ __forceinline__ unsigned xb_ld(unsigned* p)              { return __hip_atomic_load(p, __ATOMIC_RELAXED, __HIP_MEMORY_SCOPE_AGENT); }
__device__ __forceinline__ unsigned xb_add(unsigned* p, unsigned v) { return __hip_atomic_fetch_add(p, v, __ATOMIC_RELAXED, __HIP_MEMORY_SCOPE_AGENT); }
__device__ __forceinline__ unsigned xb_xcc_id() { return (unsigned)__builtin_amdgcn_s_getreg((3 << 11) | 20) & 0xFu; }
#define XB_SPIN(cond, bar) do { unsigned _sp = 0; while (cond) { __builtin_amdgcn_s_sleep(1); \
    if ((++_sp & 255u) == 0u) { if (xb_ld(&(bar)[XB_TMO])) break; if (_sp > XB_SPIN_CAP) { atomicAdd(&(bar)[XB_TMO], 1u); break; } } } } while (0)

struct XcdBarrier { unsigned* bar; unsigned x; volatile LAS unsigned* st; };

__device__ __forceinline__ XcdBarrier xcd_barrier_post(unsigned* bar, volatile LAS unsigned* st) {
    XcdBarrier b; b.bar = bar; b.x = xb_xcc_id(); b.st = st;
    if (threadIdx.x == 0) (void)xb_add(&bar[XB_XCNT(b.x)], 1u);
    return b;
}
__device__ __forceinline__ void xcd_barrier_complete(unsigned* bar, unsigned x, unsigned& nloc, unsigned& nx) {
    const unsigned G = gridDim.x * gridDim.y * gridDim.z;
    unsigned sum, cnt, mine, sp = 0u;
    for (;;) {
        sum = 0u; cnt = 0u; mine = 0u;
#pragma unroll
        for (unsigned j = 0; j < 16; ++j) { const unsigned c = xb_ld(&bar[XB_XCNT(j)]); sum += c; cnt += (c > 0u) ? 1u : 0u; mine = (j == x) ? c : mine; }
        if (sum == G) break;
        __builtin_amdgcn_s_sleep(1);
        if ((++sp & 255u) == 0u) { if (xb_ld(&bar[XB_TMO])) break; if (sp > XB_SPIN_CAP) { atomicAdd(&bar[XB_TMO], 1u); break; } }
    }
    nloc = mine > 0u ? mine : 1u; nx = cnt > 0u ? cnt : 1u;
}
__device__ __forceinline__ void xcd_barrier(const XcdBarrier& b) {
    asm volatile("s_waitcnt vmcnt(0)" ::: "memory");
    __syncthreads();
    if (threadIdx.x == 0) {
        unsigned* bar = b.bar;
        __builtin_amdgcn_s_waitcnt(0);
        unsigned nloc = b.st[0], nx = b.st[1];
        if (nloc == 0u) { xcd_barrier_complete(bar, b.x, nloc, nx); b.st[0] = nloc; b.st[1] = nx; }
        const unsigned old = xb_add(&bar[XB_XSUB(b.x)], 1u);
        const unsigned gen = old / nloc;
        if (old + 1u == (gen + 1u) * nloc) {
            __builtin_amdgcn_fence(__ATOMIC_RELEASE, "agent");
            asm volatile("s_waitcnt vmcnt(0)" ::: "memory");
            const unsigned og = xb_add(&bar[XB_TOP], 1u);
            const unsigned tg = og / nx;
            if (og + 1u == (tg + 1u) * nx) xb_add(&bar[XB_TOPGEN], 1u);
            else XB_SPIN(xb_ld(&bar[XB_TOPGEN]) == tg, bar);
            __builtin_amdgcn_fence(__ATOMIC_ACQUIRE, "agent");
            xb_add(&bar[XB_XGEN(b.x)], 1u);
            asm volatile("s_waitcnt vmcnt(0)" ::: "memory");
        } else {
            XB_SPIN(xb_ld(&bar[XB_XGEN(b.x)]) == gen, bar);
            __builtin_amdgcn_fence(__ATOMIC_ACQUIRE, "agent");
            asm volatile("s_waitcnt vmcnt(0)" ::: "memory");
        }
    }
    __syncthreads();
}

template <int MI, int NJ>
__device__ __forceinline__ void wave_mma(const bf16* (&ar)[MI], const bf16* (&br)[NJ], int K, f32x4 (&acc)[MI][NJ]) {
#pragma unroll 2
    for (int k = 0; k < K; k += 32) {
        bf16x8 a[MI], b[NJ];
#pragma unroll
        for (int i = 0; i < MI; ++i) a[i] = *(const bf16x8*)(ar[i] + k);
#pragma unroll
        for (int j = 0; j < NJ; ++j) b[j] = *(const bf16x8*)(br[j] + k);
#pragma unroll
        for (int i = 0; i < MI; ++i)
#pragma unroll
            for (int j = 0; j < NJ; ++j) acc[i][j] = __builtin_amdgcn_mfma_f32_16x16x32_bf16(b[j], a[i], acc[i][j], 0, 0, 0);
    }
}
template <int MI, int NJ>
__device__ __forceinline__ void zero_acc(f32x4 (&acc)[MI][NJ]) {
#pragma unroll
    for (int i = 0; i < MI; ++i)
#pragma unroll
        for (int j = 0; j < NJ; ++j) acc[i][j] = (f32x4){0.f, 0.f, 0.f, 0.f};
}


namespace pg8 {
constexpr int BM = 256, BK = 64, HALF = 128, HTB = HALF * BK * 2, STAGE_BYTES = 8 * HTB, NXCD = 8, WGM = 8;
__host__ __device__ __forceinline__ int lds_byte(int r, int c) { const int st = (r >> 4) * 2 + (c >> 5), rr = r & 15, cc = c & 31, ob = rr * 64 + cc * 2; return st * 1024 + (ob ^ (((ob >> 9) & 1) << 5)); }
__host__ __device__ __forceinline__ void stage_rc(int b, int& R, int& C) { const int st = b / 1024, sb = b % 1024, swz = sb ^ (((sb >> 9) & 1) << 5); R = (st >> 1) * 16 + swz / 64; C = (st & 1) * 32 + (swz % 64) / 2; }
__host__ __device__ __forceinline__ int perm32(int rho) { const int n = rho >> 4, i = rho & 15; return 8 * (i >> 2) + 4 * n + (i & 3); }
__device__ __forceinline__ unsigned cvt_pk_bf16(float lo, float hi) { unsigned r; asm volatile("v_cvt_pk_bf16_f32 %0, %1, %2" : "=v"(r) : "v"(lo), "v"(hi)); return r; }

struct Unit { int pm, pn, e, base, cnt; };

template <class Epi, class Sched, bool ALIGN_EPI>
__device__ __forceinline__ void gemm_phase(LAS unsigned char* lds, const int K, const Sched& S, const Epi& E) {
    const int tid = threadIdx.x, wid = __builtin_amdgcn_readfirstlane(tid >> 6), lane = tid & 63, wr = wid >> 2, wc = wid & 3, fr = lane & 15, fq = lane >> 4;
    const int nt = K / BK;
    unsigned voffB[2];
#pragma unroll
    for (int i = 0; i < 2; ++i) { int R, C; stage_rc(tid * 16 + i * 8192, R, C); const int Rb = Epi::PERM ? ((R & ~31) + perm32(R & 31)) : R; voffB[i] = (unsigned)(Rb * K + C) * 2u; }
    const size_t kstep = (size_t)(BK * 2);
    const size_t hB = S.b_hstep(K);
    const unsigned ldsw = (unsigned)wid * 1024u;
    const int aoff = lds_byte(wr * 64 + fr, fq * 8), boff = lds_byte(wc * 32 + fr, fq * 8);
#define PG8_SA(b, h) (((b) * 2 + (h)) * HTB)
#define PG8_SB(b, h) ((4 + (b) * 2 + (h)) * HTB)
#define PG8_STAGE(bufoff, gbase, voff) do { _Pragma("unroll") for (int _i = 0; _i < 2; ++_i) \
        __builtin_amdgcn_global_load_lds((const unsigned*)((const char*)(gbase) + (voff)[_i]), (LAS unsigned*)(lds + (bufoff) + ldsw + _i * 8192), 16, 0, 0); } while (0)
#define PG8_LDA(dst, b, h) do { _Pragma("unroll") for (int m = 0; m < 4; ++m) _Pragma("unroll") for (int k = 0; k < 2; ++k) dst[m][k] = *(const LAS bf16x8*)(lds + PG8_SA(b, h) + aoff + m * 2048 + k * 1024); } while (0)
#define PG8_LDB(dst, b, h) do { _Pragma("unroll") for (int n = 0; n < 2; ++n) _Pragma("unroll") for (int k = 0; k < 2; ++k) dst[n][k] = *(const LAS bf16x8*)(lds + PG8_SB(b, h) + boff + n * 2048 + k * 1024); } while (0)
#define PG8_MMA(ai, bj, At, Bt) do { __builtin_amdgcn_s_setprio(1); _Pragma("unroll") for (int m = 0; m < 4; ++m) _Pragma("unroll") for (int n = 0; n < 2; ++n) _Pragma("unroll") for (int k = 0; k < 2; ++k) \
        acc[ai][bj][m][n] = __builtin_amdgcn_mfma_f32_16x16x32_bf16(Bt[n][k], At[m][k], acc[ai][bj][m][n], 0, 0, 0); __builtin_amdgcn_s_setprio(0); } while (0)
#define PG8_WAIT_V(n) asm volatile("s_waitcnt vmcnt(" #n ")" ::: "memory")
#define PG8_WAIT_L(n) asm volatile("s_waitcnt lgkmcnt(" #n ")" ::: "memory")
#define PG8_BAR __builtin_amdgcn_s_barrier()
#define PG8_SCHED __builtin_amdgcn_sched_barrier(0)
    Unit cur, nxt; int ui = 0;
    if (!S.next(0, cur)) return;
    f32x4 acc[2][2][4][2];
#pragma unroll
    for (int a = 0; a < 2; ++a)
#pragma unroll
        for (int b = 0; b < 2; ++b)
#pragma unroll
            for (int m = 0; m < 4; ++m)
#pragma unroll
                for (int n = 0; n < 2; ++n) acc[a][b][m][n] = (f32x4){0.f, 0.f, 0.f, 0.f};
    bf16x8 At[4][2], B0[2][2], B1[2][2];
    unsigned va[4], vn[4];
    S.a_off(cur, tid, K, va);
    const char* cA = S.a_base(cur); const char* cB = S.b_base(cur);
    PG8_STAGE(PG8_SB(0, 0), cB, voffB); PG8_STAGE(PG8_SB(0, 1), cB + hB, voffB); PG8_STAGE(PG8_SA(0, 0), cA, va); PG8_STAGE(PG8_SA(0, 1), cA, va + 2);
    if (wr == 1) PG8_BAR;
    PG8_WAIT_V(2); PG8_BAR;
    PG8_STAGE(PG8_SB(1, 0), cB + kstep, voffB); PG8_STAGE(PG8_SA(1, 0), cA + kstep, va); PG8_STAGE(PG8_SB(1, 1), cB + hB + kstep, voffB);
    PG8_WAIT_V(6); PG8_BAR;
    for (;;) {
        const bool has_next = S.next(ui + 1, nxt);
        const char* nA = has_next ? S.a_base(nxt) : cA; const char* nB = has_next ? S.b_base(nxt) : cB;
        if constexpr (Sched::EARLY_OFF) { if (has_next) S.a_pre(nxt, tid, vn); }
#pragma nounroll
        for (int t = 0; t < nt; t += 2) {
            const bool last = (t == nt - 2);
            const char* a1 = cA + (size_t)(t + 1) * kstep;
            const char* a2 = last ? nA : cA + (size_t)(t + 2) * kstep; const char* b2 = last ? nB : cB + (size_t)(t + 2) * kstep;
            const char* a3 = a2 + kstep; const char* b3 = b2 + kstep;
            PG8_LDB(B0, 0, 0); PG8_LDB(B1, 0, 1); PG8_SCHED; PG8_LDA(At, 0, 0); PG8_STAGE(PG8_SA(1, 1), a1, va + 2);
            PG8_WAIT_V(8); PG8_WAIT_L(0); PG8_BAR; PG8_MMA(0, 0, At, B0); PG8_MMA(0, 1, At, B1); PG8_BAR; PG8_SCHED;
            if (last) {
                if (has_next) { if constexpr (Sched::EARLY_OFF) S.a_fin(nxt, tid, K, vn, va); else S.a_off(nxt, tid, K, va); } }
            PG8_LDA(At, 0, 1); PG8_STAGE(PG8_SB(0, 0), b2, voffB); PG8_STAGE(PG8_SB(0, 1), b2 + hB, voffB); PG8_STAGE(PG8_SA(0, 0), a2, va);
            PG8_WAIT_V(8); PG8_WAIT_L(0); PG8_BAR; PG8_MMA(1, 0, At, B0); PG8_MMA(1, 1, At, B1); PG8_BAR; PG8_SCHED;
            PG8_LDB(B0, 1, 0); PG8_LDB(B1, 1, 1); PG8_SCHED; PG8_LDA(At, 1, 0); PG8_STAGE(PG8_SA(0, 1), a2, va + 2);
            PG8_WAIT_V(8); PG8_WAIT_L(0); PG8_BAR; PG8_MMA(0, 0, At, B0); PG8_MMA(0, 1, At, B1); PG8_BAR; PG8_SCHED;
            PG8_LDA(At, 1, 1); PG8_STAGE(PG8_SB(1, 0), b3, voffB); PG8_STAGE(PG8_SB(1, 1), b3 + hB, voffB); PG8_STAGE(PG8_SA(1, 0), a3, va);
            PG8_WAIT_V(8); PG8_WAIT_L(0); PG8_BAR; PG8_MMA(1, 0, At, B0); PG8_MMA(1, 1, At, B1); PG8_BAR; PG8_SCHED;
        }
        if constexpr (ALIGN_EPI) { if (wr == 0) PG8_BAR; }
        E(acc, cur, wr, wc, fr, fq);
        if (!has_next) break;
#pragma unroll
        for (int a = 0; a < 2; ++a)
#pragma unroll
            for (int b = 0; b < 2; ++b)
#pragma unroll
                for (int m = 0; m < 4; ++m)
#pragma unroll
                    for (int n = 0; n < 2; ++n) acc[a][b][m][n] = (f32x4){0.f, 0.f, 0.f, 0.f};
        cur = nxt; cA = nA; cB = nB; ++ui;
        if constexpr (ALIGN_EPI) { if (wr == 1) PG8_BAR; }
    }
    PG8_WAIT_V(0);
    if constexpr (!ALIGN_EPI) { if (wr == 0) PG8_BAR; }
    PG8_BAR;
#undef PG8_SA
#undef PG8_SB
#undef PG8_STAGE
#undef PG8_LDA
#undef PG8_LDB
#undef PG8_MMA
#undef PG8_WAIT_V
#undef PG8_WAIT_L
#undef PG8_BAR
#undef PG8_SCHED
}

__device__ __forceinline__ int xcd_deal(int i, int G, int c, int total) {
    const int per = (total + 7) >> 3, x = c & 7, j = i * (G >> 3) + (c >> 3);
    if (j >= per) return -1; const int u = x * per + j; return u < total ? u : -1;
}

struct DenseSched {
    static constexpr bool EARLY_OFF = false;
    const char* A; const char* Bt; int nM, nN, nwg, G, c, K;
    __device__ __forceinline__ void init(const void* A_, const void* Bt_, int M, int N, int K_, int G_, int c_) { A = (const char*)A_; Bt = (const char*)Bt_; nM = M / BM; nN = N / BM; nwg = nM * nN; G = G_; c = c_; K = K_; }
    __device__ __forceinline__ bool next(int i, Unit& u) const {
        const long L = (long)i * G + c; if (L >= nwg) return false;
        int wgid = (int)L; { const int q = nwg / NXCD, r = nwg % NXCD, xcd = wgid % NXCD, off = wgid / NXCD; wgid = (xcd < r ? xcd * (q + 1) : r * (q + 1) + (xcd - r) * q) + off; }
        const int nig = WGM * nN, gid = wgid / nig, fm = gid * WGM, gsz = (nM - fm) < WGM ? (nM - fm) : WGM;
        u.pm = fm + ((wgid % nig) % gsz); u.pn = (wgid % nig) / gsz; u.e = 0; u.base = u.pm * BM; u.cnt = BM; return true;
    }
    __device__ __forceinline__ const char* a_base(const Unit&) const { return A; }
    __device__ __forceinline__ void a_off(const Unit& u, int tid, int K_, unsigned (&vo)[4]) const {
        asm volatile("" : "+v"(tid)); int Ra[2], Ca[2]; stage_rc(tid * 16, Ra[0], Ca[0]); stage_rc(tid * 16 + 8192, Ra[1], Ca[1]);
#pragma unroll
        for (int h = 0; h < 2; ++h)
#pragma unroll
            for (int i = 0; i < 2; ++i) vo[h * 2 + i] = (unsigned)((u.pm * BM + h * HALF + Ra[i]) * K_ + Ca[i]) * 2u;
    }
    __device__ __forceinline__ const char* b_base(const Unit& u) const { return Bt + (size_t)u.pn * BM * K * 2; }
    __device__ __forceinline__ size_t b_hstep(int K_) const { return (size_t)HALF * K_ * 2; }
};
}

struct ProjSched {
    static constexpr bool EARLY_OFF = false;
    const char *XBp, *WINp, *MEMBp, *WKVp; int G, c;
    __device__ __forceinline__ bool next(int i, pg8::Unit& u) const {
        const int L = i * G + c; if (L >= 416) return false;
        int pm, pn, e;
        if (L < 384) { const int wgid = (L & 7) * 48 + (L >> 3);
            pm = (wgid / 48) * 8 + (wgid % 48) % 8; pn = (wgid % 48) / 8; e = 0; }
        else { const int q = L - 384; pm = q >> 3; pn = q & 7; e = 1; }
        u.pm = pm; u.pn = pn; u.e = e; u.base = pm * 256; u.cnt = 256;
        return true;
    }
    __device__ __forceinline__ const char* a_base(const pg8::Unit& u) const { return u.e ? MEMBp : XBp; }
    __device__ __forceinline__ void a_off(const pg8::Unit& u, int tid, int K_, unsigned (&vo)[4]) const {
        asm volatile("" : "+v"(tid)); int Ra[2], Ca[2]; pg8::stage_rc(tid * 16, Ra[0], Ca[0]); pg8::stage_rc(tid * 16 + 8192, Ra[1], Ca[1]);
#pragma unroll
        for (int h = 0; h < 2; ++h)
#pragma unroll
            for (int i = 0; i < 2; ++i) vo[h * 2 + i] = (unsigned)((u.pm * 256 + h * 128 + Ra[i]) * K_ + Ca[i]) * 2u;
    }
    __device__ __forceinline__ const char* b_base(const pg8::Unit& u) const { return (u.e ? WKVp : WINp) + (size_t)u.pn * 256 * 1024 * 2; }
    __device__ __forceinline__ size_t b_hstep(int K_) const { return (size_t)128 * K_ * 2; }
};
struct EpiProj {
    static constexpr bool PERM = true;
    bf16 *CV, *AS, *KB, *VT;
    __device__ __forceinline__ void operator()(const f32x4 (&acc)[2][2][4][2], const pg8::Unit& u, int wr, int wc, int fr, int fq) const {
        int r0 = wr * 64 + fr; asm volatile("" : "+v"(r0));
#pragma unroll
        for (int ai = 0; ai < 2; ++ai)
#pragma unroll
            for (int m = 0; m < 4; ++m) { const int row = u.pm * 256 + ai * 128 + m * 16 + r0;
#pragma unroll
                for (int bj = 0; bj < 2; ++bj) { const int col = u.pn * 256 + bj * 128 + wc * 32 + 8 * fq; const f32x4 v0 = acc[ai][bj][m][0], v1 = acc[ai][bj][m][1];
                    v4u w; w.x = cvtpk(v0[0], v0[1]); w.y = cvtpk(v0[2], v0[3]); w.z = cvtpk(v1[0], v1[1]); w.w = cvtpk(v1[2], v1[3]);
                    if (u.e == 0) { if (u.pn < 4) *(v4u*)(CV + (size_t)row * 1024 + col) = w;
                        else { const int ch = col - 1024, g = ch >> 4, h = ch & 15; *(v4u*)(AS + ((size_t)(g * NCH + (row >> 4)) * 384 + (row & 15) * 16 + h)) = w; } }
                    else { if (u.pn < 4) *(v4u*)(KB + (size_t)row * 1024 + col) = w;
                        else { const int d = col - 1024, b = row >> 8, key = row & 255; bf16* vp = VT + ((size_t)(b * 1024 + d)) * 256 + key;
                            vp[0 * 256] = (bf16)(w.x & 0xffffu); vp[1 * 256] = (bf16)(w.x >> 16); vp[2 * 256] = (bf16)(w.y & 0xffffu); vp[3 * 256] = (bf16)(w.y >> 16);
                            vp[4 * 256] = (bf16)(w.z & 0xffffu); vp[5 * 256] = (bf16)(w.z >> 16); vp[6 * 256] = (bf16)(w.w & 0xffffu); vp[7 * 256] = (bf16)(w.w >> 16); } } } }
    }
};
struct EpiResF32 {
    static constexpr bool PERM = false;
    const float* res; float* out;
    __device__ __forceinline__ void operator()(const f32x4 (&acc)[2][2][4][2], const pg8::Unit& u, int wr, int wc, int fr, int fq) const {
        int r0 = wr * 64 + fr; asm volatile("" : "+v"(r0));
#pragma unroll
        for (int ai = 0; ai < 2; ++ai)
#pragma unroll
            for (int m = 0; m < 4; ++m) { const size_t ro = (size_t)(u.pm * 256 + ai * 128 + m * 16 + r0) * D + u.pn * 256 + wc * 32 + 4 * fq;
#pragma unroll
                for (int bj = 0; bj < 2; ++bj)
#pragma unroll
                    for (int n = 0; n < 2; ++n) { const size_t o = ro + bj * 128 + n * 16; const f32x4 r = *(const f32x4*)(res + o); *(f32x4*)(out + o) = r * ALPHA + acc[ai][bj][m][n]; } }
    }
};
struct EpiBf16S {
    static constexpr bool PERM = true;
    bf16* out; float scale;
    __device__ __forceinline__ void operator()(const f32x4 (&acc)[2][2][4][2], const pg8::Unit& u, int wr, int wc, int fr, int fq) const {
        int r0 = wr * 64 + fr; asm volatile("" : "+v"(r0));
#pragma unroll
        for (int ai = 0; ai < 2; ++ai)
#pragma unroll
            for (int m = 0; m < 4; ++m) { const size_t ro = (size_t)(u.pm * 256 + ai * 128 + m * 16 + r0) * D + u.pn * 256 + wc * 32 + 8 * fq;
#pragma unroll
                for (int bj = 0; bj < 2; ++bj) { const f32x4 v0 = acc[ai][bj][m][0] * scale, v1 = acc[ai][bj][m][1] * scale;
                    v4u w; w.x = cvtpk(v0[0], v0[1]); w.y = cvtpk(v0[2], v0[3]); w.z = cvtpk(v1[0], v1[1]); w.w = cvtpk(v1[2], v1[3]);
                    *(v4u*)(out + ro + bj * 128) = w; } }
    }
};

template <int KK>
struct SsmSched {
    static constexpr bool EARLY_OFF = false;
    const char* ASp; const char* Wp; int G, c;
    __device__ __forceinline__ bool next(int i, pg8::Unit& u) const {
        const int L = i * G + c; if (L >= NG * 4) return false;
        const int idx = (L & 7) * 16 + (L >> 3);
        u.e = idx >> 2; u.pm = idx & 3; u.pn = 0; u.base = u.e * NCH + u.pm * 256; u.cnt = 256; return true;
    }
    __device__ __forceinline__ const char* a_base(const pg8::Unit&) const { return ASp; }
    __device__ __forceinline__ void a_off(const pg8::Unit& u, int tid, int K_, unsigned (&vo)[4]) const {
        asm volatile("" : "+v"(tid)); int Ra[2], Ca[2]; pg8::stage_rc(tid * 16, Ra[0], Ca[0]); pg8::stage_rc(tid * 16 + 8192, Ra[1], Ca[1]);
#pragma unroll
        for (int h = 0; h < 2; ++h)
#pragma unroll
            for (int i = 0; i < 2; ++i) vo[h * 2 + i] = (unsigned)((u.base + h * 128 + Ra[i]) * 384 + Ca[i]) * 2u;
    }
    __device__ __forceinline__ const char* b_base(const pg8::Unit& u) const { return Wp + (size_t)u.e * 256 * KK * 2; }
    __device__ __forceinline__ size_t b_hstep(int K_) const { return (size_t)128 * K_ * 2; }
};
struct EpiSend {
    static constexpr bool PERM = false;
    float* out;
    __device__ __forceinline__ void operator()(const f32x4 (&acc)[2][2][4][2], const pg8::Unit& u, int wr, int wc, int fr, int fq) const {
        int r0 = wr * 64 + fr; asm volatile("" : "+v"(r0));
#pragma unroll
        for (int ai = 0; ai < 2; ++ai)
#pragma unroll
            for (int m = 0; m < 4; ++m) { float* rp = out + (size_t)(u.base + ai * 128 + m * 16 + r0) * 128 + wc * 32 + 4 * fq;
#pragma unroll
                for (int n = 0; n < 2; ++n) *(f32x4*)(rp + n * 16) = acc[ai][0][m][n]; }
    }
};
struct EpiSsmY {
    static constexpr bool PERM = true;
    const bf16* AS; const float* dskip; bf16* Z;
    __device__ __forceinline__ void operator()(const f32x4 (&acc)[2][2][4][2], const pg8::Unit& u, int wr, int wc, int fr, int fq) const {
        int r0 = wr * 64 + fr; asm volatile("" : "+v"(r0));
        const int g = u.e;
#pragma unroll
        for (int bj = 0; bj < 2; ++bj) { const int n = bj * 128 + wc * 32 + 8 * fq, ti = n >> 4, hh = n & 15;
            const f32x4 d0 = *(const f32x4*)(dskip + g * 16 + hh), d1 = *(const f32x4*)(dskip + g * 16 + hh + 4);
#pragma unroll
            for (int ai = 0; ai < 2; ++ai)
#pragma unroll
                for (int m = 0; m < 4; ++m) { const int r = u.base + ai * 128 + m * 16 + r0;
                    const v4u uu = *(const v4u*)(AS + (size_t)r * 384 + n); const f32x4 a0 = acc[ai][bj][m][0], a1 = acc[ai][bj][m][1];
                    v4u w; w.x = cvtpk(gelu_tanh(a0[0] + d0[0] * bflo(uu.x)), gelu_tanh(a0[1] + d0[1] * bfhi(uu.x))); w.y = cvtpk(gelu_tanh(a0[2] + d0[2] * bflo(uu.y)), gelu_tanh(a0[3] + d0[3] * bfhi(uu.y)));
                    w.z = cvtpk(gelu_tanh(a1[0] + d1[0] * bflo(uu.z)), gelu_tanh(a1[1] + d1[1] * bfhi(uu.z))); w.w = cvtpk(gelu_tanh(a1[2] + d1[2] * bflo(uu.w)), gelu_tanh(a1[3] + d1[3] * bfhi(uu.w)));
                    *(v4u*)(Z + ((size_t)((r - g * NCH) * 16 + ti)) * 512 + g * 16 + hh) = w; } }
    }
};
struct EpiGlu {
    static constexpr bool PERM = true;
    const bf16* Z; const float* bias; float* ZG;
    __device__ __forceinline__ void operator()(const f32x4 (&acc)[2][2][4][2], const pg8::Unit& u, int wr, int wc, int fr, int fq) const {
        int r0 = wr * 64 + fr; asm volatile("" : "+v"(r0));
#pragma unroll
        for (int bj = 0; bj < 2; ++bj) { const int n = u.pn * 256 + bj * 128 + wc * 32 + 8 * fq;
            const f32x4 b0 = *(const f32x4*)(bias + n), b1 = *(const f32x4*)(bias + n + 4);
#pragma unroll
            for (int ai = 0; ai < 2; ++ai)
#pragma unroll
                for (int m = 0; m < 4; ++m) { const size_t o = (size_t)(u.pm * 256 + ai * 128 + m * 16 + r0) * 512 + n;
                    const v4u zz = *(const v4u*)(Z + o); const f32x4 a0 = acc[ai][bj][m][0], a1 = acc[ai][bj][m][1];
                    f32x4 o0, o1; o0[0] = bflo(zz.x) * sigmoidf_(a0[0] + b0[0]); o0[1] = bfhi(zz.x) * sigmoidf_(a0[1] + b0[1]); o0[2] = bflo(zz.y) * sigmoidf_(a0[2] + b0[2]); o0[3] = bfhi(zz.y) * sigmoidf_(a0[3] + b0[3]);
                    o1[0] = bflo(zz.z) * sigmoidf_(a1[0] + b1[0]); o1[1] = bfhi(zz.z) * sigmoidf_(a1[1] + b1[1]); o1[2] = bflo(zz.w) * sigmoidf_(a1[2] + b1[2]); o1[3] = bfhi(zz.w) * sigmoidf_(a1[3] + b1[3]);
                    *(f32x4*)(ZG + o) = o0; *(f32x4*)(ZG + o + 4) = o1; } }
    }
};
struct EpiF32 {
    static constexpr bool PERM = false;
    float* out; int ld;
    __device__ __forceinline__ void operator()(const f32x4 (&acc)[2][2][4][2], const pg8::Unit& u, int wr, int wc, int fr, int fq) const {
        int r0 = wr * 64 + fr; asm volatile("" : "+v"(r0));
#pragma unroll
        for (int ai = 0; ai < 2; ++ai)
#pragma unroll
            for (int m = 0; m < 4; ++m) { float* rp = out + (size_t)(u.pm * 256 + ai * 128 + m * 16 + r0) * ld + u.pn * 256 + wc * 32 + 4 * fq;
#pragma unroll
                for (int bj = 0; bj < 2; ++bj)
#pragma unroll
                    for (int n = 0; n < 2; ++n) *(f32x4*)(rp + bj * 128 + n * 16) = acc[ai][bj][m][n]; }
    }
};
template <bool GATEUP>
struct MoeSched {
    static constexpr int NPN = GATEUP ? 2 : 4; static constexpr bool EARLY_OFF = GATEUP;
    const bf16 *X, *XS, *W, *WS; const int* stok; const LAS int* off; const LAS int* tst; int nmoe, total, G, c; LAS unsigned char* tokl;
    __device__ __forceinline__ bool next(int i, pg8::Unit& u) const {
        const int idx = pg8::xcd_deal(i, G, c, total); if (idx < 0) return false;
        const int mtg = idx / NPN; u.pn = idx % NPN;
        if (mtg >= nmoe) { u.e = 256; u.pm = mtg - nmoe; u.base = (GATEUP ? NASSIGN : 0) + u.pm * 256; u.cnt = 256; }
        else { int lo_ = 0, hi_ = 256; while (hi_ - lo_ > 1) { const int mid = (lo_ + hi_) >> 1; if (tst[mid] <= mtg) lo_ = mid; else hi_ = mid; }
            u.e = lo_; u.pm = mtg - tst[lo_]; u.base = off[lo_] + u.pm * 256; u.cnt = off[lo_ + 1] - u.base; }
        u.e = __builtin_amdgcn_readfirstlane(u.e); u.pm = __builtin_amdgcn_readfirstlane(u.pm); u.pn = __builtin_amdgcn_readfirstlane(u.pn);
        u.base = __builtin_amdgcn_readfirstlane(u.base); u.cnt = __builtin_amdgcn_readfirstlane(u.cnt);
        return true;
    }
    __device__ __forceinline__ const char* a_base(const pg8::Unit& u) const { return (const char*)((!GATEUP && u.e == 256) ? XS : X); }
    __device__ __forceinline__ void a_pre(const pg8::Unit& u, int tid, unsigned (&vr)[4]) const {
        asm volatile("" : "+v"(tid)); int Ra[2], Ca[2]; pg8::stage_rc(tid * 16, Ra[0], Ca[0]); pg8::stage_rc(tid * 16 + 8192, Ra[1], Ca[1]);
        if constexpr (GATEUP) { const int* sp = stok + u.base; const int cm = u.cnt - 1;
            const int wv = __builtin_amdgcn_readfirstlane(tid >> 6);
#pragma unroll
            for (int h = 0; h < 2; ++h)
#pragma unroll
                for (int i = 0; i < 2; ++i) { const int r = h * 128 + Ra[i];
                    __builtin_amdgcn_global_load_lds((const unsigned*)(sp + (r < cm ? r : cm)), (LAS unsigned*)(tokl + wv * 1024 + (h * 2 + i) * 256), 4, 0, 0); vr[h * 2 + i] = 0u; } }
        else {
#pragma unroll
            for (int h = 0; h < 2; ++h)
#pragma unroll
                for (int i = 0; i < 2; ++i) vr[h * 2 + i] = (unsigned)(u.base + h * 128 + Ra[i]); }
    }
    __device__ __forceinline__ void a_fin(const pg8::Unit& u, int tid, int K_, const unsigned (&vr)[4], unsigned (&vo)[4]) const {
        asm volatile("" : "+v"(tid)); int Ra[2], Ca[2]; pg8::stage_rc(tid * 16, Ra[0], Ca[0]); pg8::stage_rc(tid * 16 + 8192, Ra[1], Ca[1]);
#pragma unroll
        for (int h = 0; h < 2; ++h)
#pragma unroll
            for (int i = 0; i < 2; ++i) { unsigned rv;
                if constexpr (GATEUP) rv = *(const LAS unsigned*)(tokl + (tid >> 6) * 1024 + (h * 2 + i) * 256 + (tid & 63) * 4); else rv = vr[h * 2 + i];
                vo[h * 2 + i] = (rv * (unsigned)K_ + (unsigned)Ca[i]) * 2u; }
    }
    __device__ __forceinline__ void a_off(const pg8::Unit& u, int tid, int K_, unsigned (&vo)[4]) const { unsigned vr[4]; a_pre(u, tid, vr); if constexpr (GATEUP) asm volatile("s_waitcnt vmcnt(0)" ::: "memory"); a_fin(u, tid, K_, vr, vo); }
    __device__ __forceinline__ const char* b_base(const pg8::Unit& u) const {
        if (GATEUP) return (const char*)((u.e == 256 ? WS : W + (size_t)u.e * 512 * 1024) + (size_t)u.pn * 128 * 1024);
        else return (const char*)((u.e == 256 ? WS : W + (size_t)u.e * 1024 * 256) + (size_t)u.pn * 256 * 256);
    }
    __device__ __forceinline__ size_t b_hstep(int K_) const { return GATEUP ? (size_t)256 * K_ * 2 : (size_t)128 * K_ * 2; }
};
struct EpiGateUp {
    static constexpr bool PERM = true;
    bf16 *H, *HS;
    __device__ __forceinline__ void operator()(const f32x4 (&acc)[2][2][4][2], const pg8::Unit& u, int wr, int wc, int fr, int fq) const {
        int r0 = wr * 64 + fr; asm volatile("" : "+v"(r0));
        bf16* bp = H + (size_t)u.base * DE + u.pn * 128 + wc * 32 + 8 * fq;
#pragma unroll
        for (int ai = 0; ai < 2; ++ai)
#pragma unroll
            for (int m = 0; m < 4; ++m) { const int r = ai * 128 + m * 16 + r0;
                if (r < u.cnt) { float hv[8];
#pragma unroll
                    for (int n = 0; n < 2; ++n)
#pragma unroll
                        for (int j = 0; j < 4; ++j) { const float g = acc[ai][0][m][n][j], up = acc[ai][1][m][n][j]; hv[n * 4 + j] = g * sigmoidf_(g) * up; }
                    v4u w; w.x = cvtpk(hv[0], hv[1]); w.y = cvtpk(hv[2], hv[3]); w.z = cvtpk(hv[4], hv[5]); w.w = cvtpk(hv[6], hv[7]);
                    *(v4u*)(bp + (size_t)r * DE) = w; } }
    }
};
struct EpiDown {
    static constexpr bool PERM = true;
    bf16 *Y, *YS; const float* sgate;
    __device__ __forceinline__ void operator()(const f32x4 (&acc)[2][2][4][2], const pg8::Unit& u, int wr, int wc, int fr, int fq) const {
        int r0 = wr * 64 + fr; asm volatile("" : "+v"(r0));
        bf16* bp = (u.e == 256 ? YS : Y) + (size_t)u.base * D + u.pn * 256 + wc * 32 + 8 * fq;
#pragma unroll
        for (int ai = 0; ai < 2; ++ai)
#pragma unroll
            for (int m = 0; m < 4; ++m) { const int r = ai * 128 + m * 16 + r0;
                if (r < u.cnt) { const float gt = (u.e == 256) ? 1.0f : sgate[u.base + r];
#pragma unroll
                    for (int bj = 0; bj < 2; ++bj) { const f32x4 v0 = acc[ai][bj][m][0] * gt, v1 = acc[ai][bj][m][1] * gt;
                        v4u w; w.x = cvtpk(v0[0], v0[1]); w.y = cvtpk(v0[2], v0[3]); w.z = cvtpk(v1[0], v1[1]); w.w = cvtpk(v1[2], v1[3]);
                        *(v4u*)(bp + (size_t)r * D + bj * 128) = w; } } }
    }
};

__device__ __forceinline__ void p0_transpose_item(const float* W, int K, int N, bf16* WT, int row_off, LAS unsigned char* scr, int item, int lane) {
    const int nblk = N / 64, kb = item / nblk, nb = item % nblk, k0 = 64 * kb, n0 = 64 * nb;
    const float* src = W + (size_t)k0 * N + n0 + lane;
    float v[64];
#pragma unroll
    for (int j = 0; j < 64; ++j) v[j] = __builtin_nontemporal_load(src + (size_t)j * N);
#pragma unroll
    for (int g = 0; g < 8; ++g) { v4u o; o.x = pk2(v[8 * g], v[8 * g + 1]); o.y = pk2(v[8 * g + 2], v[8 * g + 3]); o.z = pk2(v[8 * g + 4], v[8 * g + 5]); o.w = pk2(v[8 * g + 6], v[8 * g + 7]);
        *(LAS v4u*)(scr + lane * 144 + g * 16) = o; }
    LDS_WAIT(); asm volatile("" ::: "memory");
    bf16* dst = WT + (size_t)(row_off + n0 + (lane >> 3)) * K + k0 + (lane & 7) * 8;
#pragma unroll
    for (int j = 0; j < 8; ++j) { const v4u o = *(const LAS v4u*)(scr + (8 * j + (lane >> 3)) * 144 + (lane & 7) * 16); *(v4u*)(dst + (size_t)(8 * j) * K) = o; }
    LDS_WAIT(); asm volatile("" ::: "memory");
}

__device__ __forceinline__ void sincos_d(double x, float& s, float& c) {
    const double k = __builtin_rint(x * 0.63661977236758134308);
    double r = __builtin_fma(-k, 1.57079632679489655800e+00, x); r = __builtin_fma(-k, 6.12323399573676603587e-17, r);
    const int q = ((int)k) & 3;
    const float rf = (float)r, z = rf * rf;
    const float sp = rf + rf * z * (-1.6666667163e-01f + z * (8.3333337680e-03f + z * (-1.9841270114e-04f + z * 2.7557314297e-06f)));
    const float cp = 1.0f - 0.5f * z + z * z * (4.1666667908e-02f + z * (-1.3888889225e-03f + z * (2.4801587642e-05f + z * -2.7557314297e-07f)));
    s = (q == 0) ? sp : (q == 1) ? cp : (q == 2) ? -sp : -cp;
    c = (q == 0) ? cp : (q == 1) ? -sp : (q == 2) ? -cp : sp;
}

__device__ __forceinline__ void p0_ssm_group(int g, int jpart, int tid, LAS unsigned char* lds, const float* log_dt, const float* a_re, const float* a_im,
                                             const float* b_re, const float* b_im, const float* c_re, const float* c_im, bf16* W1, bf16* W2, float* LAM16) {
    LAS float* lp_re = (LAS float*)lds;
    LAS float* lp_im = lp_re + 17 * 64;
    LAS float* bb_re = lp_im + 17 * 64;
    LAS float* bb_im = bb_re + 1024;
    LAS float* cc_re = bb_im + 1024;
    LAS float* cc_im = cc_re + 1024;
    LAS float* ktab = cc_im + 1024;
    __syncthreads();
    const float dt = __expf(log_dt[g]);
    if (tid < 64) {
        const int p = tid; const float a = a_re[g * 64 + p], w = a_im[g * 64 + p];
        for (int tau = 0; tau <= 16; ++tau) { float s, c; sincos_d((double)w * (double)dt * (double)tau, s, c); const float mg = __expf(a * dt * (float)tau);
            lp_re[tau * 64 + p] = mg * c; lp_im[tau * 64 + p] = mg * s; }
        const float lr = lp_re[64 + p], li = lp_im[64 + p];
        const float den = a * a + w * w;
        const float cr = ((lr - 1.0f) * a + li * w) / den, ci = (li * a - (lr - 1.0f) * w) / den;
        for (int h = 0; h < 16; ++h) { const float br = b_re[(g * 64 + p) * 16 + h], bi = b_im[(g * 64 + p) * 16 + h];
            bb_re[p * 16 + h] = cr * br - ci * bi; bb_im[p * 16 + h] = cr * bi + ci * br; }
        if (jpart == 0) { LAM16[(g * 64 + p) * 2 + 0] = lp_re[16 * 64 + p]; LAM16[(g * 64 + p) * 2 + 1] = lp_im[16 * 64 + p]; }
    }
    for (int i = tid; i < 1024; i += NTHR) { cc_re[i] = c_re[g * 1024 + i]; cc_im[i] = c_im[g * 1024 + i]; }
    __syncthreads();
    {
        const int e = tid, tau = e >> 5, hl = (e >> 4) & 1, hp = e & 15, h = 2 * jpart + hl; float acc = 0.f;
        for (int p = 0; p < 64; ++p) { const float lr = lp_re[tau * 64 + p], li = lp_im[tau * 64 + p], br = bb_re[p * 16 + hp], bi = bb_im[p * 16 + hp];
            const float zr = lr * br - li * bi, zi = lr * bi + li * br;
            acc += cc_re[h * 64 + p] * zr - cc_im[h * 64 + p] * zi; }
        ktab[e] = acc; }
    __syncthreads();
    bf16* w1 = W1 + (size_t)g * 256 * 256 + (size_t)jpart * 32 * 256;
    for (int e = tid; e < 32 * 256; e += NTHR) { const int n = jpart * 32 + (e >> 8), k = e & 255, p = n & 63, j = k >> 4, hp = k & 15, tau = 15 - j;
        const float lr = lp_re[tau * 64 + p], li = lp_im[tau * 64 + p], br = bb_re[p * 16 + hp], bi = bb_im[p * 16 + hp];
        const float v = (n < 64) ? (lr * br - li * bi) : (n < 128) ? (lr * bi + li * br) : 0.f;
        w1[e] = (bf16)f2bf(v); }
    bf16* w2 = W2 + (size_t)g * 256 * 384;
    for (int e = tid; e < 32 * 384; e += NTHR) { const int rr = e / 384, k = e % 384, i = rr >> 1, hl = rr & 1, h = 2 * jpart + hl, n = i * 16 + h; float v;
        if (k < 256) { const int j = k >> 4, hp = k & 15; v = (j <= i) ? ktab[((i - j) << 5) + (hl << 4) + hp] : 0.f; }
        else { const int q = k - 256, p = q & 63, tau = i + 1; const float lr = lp_re[tau * 64 + p], li = lp_im[tau * 64 + p], cr = cc_re[h * 64 + p], ci = cc_im[h * 64 + p];
            v = (q < 64) ? (cr * lr - ci * li) : -(cr * li + ci * lr); }
        w2[(size_t)n * 384 + k] = (bf16)f2bf(v); }
    __syncthreads();
}

struct Args { const float* in[38]; float* out; unsigned char* ws; int ph_lo, ph_hi; };

constexpr int N_PHASES = 19;

__global__ void __launch_bounds__(NTHR, 2) fwd(Args args) {
    extern __shared__ __attribute__((aligned(16))) unsigned char lds_raw[];
    LAS unsigned char* lds = (LAS unsigned char*)lds_raw;
    volatile LAS unsigned* MISC = (volatile LAS unsigned*)(lds + MISC_OFF);
    const int tid = threadIdx.x, lane = tid & 63, wave = __builtin_amdgcn_readfirstlane(tid >> 6);
    const int G = gridDim.x; const int bx = blockIdx.x; const int vcu = (G % 8 == 0) ? (bx % 8) * (G / 8) + bx / 8 : bx;
    const int gw = vcu * NWAVES + wave, ngw = G * NWAVES;
    const int gtid = vcu * NTHR + tid, ngt = G * NTHR;
    const int fr = lane & 15, fq = lane >> 4;
    unsigned char* ws = args.ws;
    unsigned* ctl = (unsigned*)(ws + WS_CTL);
    for (int u = tid; u < (LDS_BYTES - 131072) / 4; u += NTHR) ((LAS unsigned*)(lds + 131072))[u] = 0u;
    __syncthreads();
#if MK_SPLIT
#define GRID_BAR() do { } while (0)
#else
    XcdBarrier bar = xcd_barrier_post(ctl + CW_BAR, MISC + 8);
#define GRID_BAR() xcd_barrier(bar)
#endif
    const int lo = args.ph_lo, hi = args.ph_hi;
#ifndef PROBE_MASK
#define PROBE_MASK 0u
#endif
#define NREP(k) (((PROBE_MASK >> (k)) & 1u) ? 2 : 1)
#ifndef PROBE_DUP_P0
#define PROBE_DUP_P0 0
#endif
#ifndef ONLY_PHASE
#define ONLY_PHASE -1
#endif
#define IN(k) ((ONLY_PHASE < 0 || ONLY_PHASE == (k)) && lo <= (k) && (k) < hi)
#define BOTH(k) (IN(k) && IN((k) + 1))

    const float* x = args.in[0];
    bf16* XB = (bf16*)(ws + WS_XB); bf16* CV = (bf16*)(ws + WS_CV); bf16* AS = (bf16*)(ws + WS_AS); float* SEND = (float*)(ws + WS_SEND);
    bf16* Z = (bf16*)(ws + WS_Z); float* ZG = (float*)(ws + WS_ZG); bf16* MERGED = (bf16*)(ws + WS_MERGED); float* Y1 = (float*)(ws + WS_Y1);
    float* X1 = (float*)(ws + WS_X1); bf16* X1B = (bf16*)(ws + WS_X1B); bf16* Q = (bf16*)(ws + WS_Q); bf16* O = (bf16*)(ws + WS_O);
    float* X2 = (float*)(ws + WS_X2); bf16* X2B = (bf16*)(ws + WS_X2B); float* LOGITS = (float*)(ws + WS_LOGITS);
    bf16* H = (bf16*)(ws + WS_H); bf16* HS = (bf16*)(ws + WS_HS); bf16* Y = (bf16*)(ws + WS_Y); bf16* YS = (bf16*)(ws + WS_YS);
    bf16* W_IN_T = (bf16*)(ws + WS_W_IN_T); bf16* W_GLU_T = (bf16*)(ws + WS_W_GLU_T); bf16* W_OUT_T = (bf16*)(ws + WS_W_OUT_T);
    bf16* WQ_T = (bf16*)(ws + WS_WQ_T); bf16* WKV_T = (bf16*)(ws + WS_WKV_T); bf16* WO_T = (bf16*)(ws + WS_WO_T); bf16* WR_T = (bf16*)(ws + WS_WR_T);
    bf16* SSM_W1 = (bf16*)(ws + WS_SSM_W1); bf16* SSM_W2 = (bf16*)(ws + WS_SSM_W2); float* LAM16 = (float*)(ws + WS_LAM16);
    bf16* SH_GU_T = (bf16*)(ws + WS_SH_GU_T); bf16* SH_D_T = (bf16*)(ws + WS_SH_D_T);
    bf16* MEMB = (bf16*)(ws + WS_MEMB); bf16* KB = (bf16*)(ws + WS_KB); bf16* VT = (bf16*)(ws + WS_VT);
    bf16* WGU_T = (bf16*)(ws + WS_WGU_T); bf16* WD_T = (bf16*)(ws + WS_WD_T);
    int* TOPE = (int*)(ws + WS_TOPE); int* TOPP = (int*)(ws + WS_TOPP); float* GATE = (float*)(ws + WS_GATE); int* SLOT = (int*)(ws + WS_SLOT);
    int* STOK = (int*)(ws + WS_STOK); float* SGATE = (float*)(ws + WS_SGATE);
    unsigned* CNT = ctl + CW_CNT;

    if (IN(0)) {
        LAS unsigned char* scr = lds + wave * 9216;
        constexpr int I_SMALL = 384 + 64 + 256 * 4 + 256 + 64 * 4;
        for (int rep = 0; rep <= PROBE_DUP_P0; ++rep)
        for (int mi = vcu; mi < NE * 3; mi += G) { const int e = mi / 3, w3 = mi % 3;
            for (int q = wave; q < 64; q += NWAVES) {
                if (w3 == 0) p0_transpose_item(args.in[30] + (size_t)e * D * DE, D, DE, WGU_T + (size_t)e * 512 * D, 0, scr, q, lane);
                else if (w3 == 1) p0_transpose_item(args.in[31] + (size_t)e * D * DE, D, DE, WGU_T + (size_t)e * 512 * D, 256, scr, q, lane);
                else p0_transpose_item(args.in[32] + (size_t)e * DE * D, DE, D, WD_T + (size_t)e * D * DE, 0, scr, q, lane); } }
        for (int it = gw; it < I_SMALL; it += ngw) {
            int r = it;
            if (r < 384) { p0_transpose_item(args.in[2], D, 1536, W_IN_T, 0, scr, r, lane); continue; } r -= 384;
            if (r < 64) { p0_transpose_item(args.in[15], 512, 512, W_GLU_T, 0, scr, r, lane); continue; } r -= 64;
            if (r < 256) { p0_transpose_item(args.in[19], D, D, W_OUT_T, 0, scr, r, lane); continue; } r -= 256;
            if (r < 256) { p0_transpose_item(args.in[22], D, D, WQ_T, 0, scr, r, lane); continue; } r -= 256;
            if (r < 256) { p0_transpose_item(args.in[23], D, D, WKV_T, 0, scr, r, lane); continue; } r -= 256;
            if (r < 256) { p0_transpose_item(args.in[24], D, D, WKV_T, 1024, scr, r, lane); continue; } r -= 256;
            if (r < 256) { p0_transpose_item(args.in[25], D, D, WO_T, 0, scr, r, lane); continue; } r -= 256;
            if (r < 64) { p0_transpose_item(args.in[28], D, 256, WR_T, 0, scr, r, lane); continue; } r -= 64;
            if (r < 64) { p0_transpose_item(args.in[33], D, 256, SH_GU_T, 0, scr, r, lane); continue; } r -= 64;
            if (r < 64) { p0_transpose_item(args.in[34], D, 256, SH_GU_T, 256, scr, r, lane); continue; } r -= 64;
            p0_transpose_item(args.in[35], 256, D, SH_D_T, 0, scr, r, lane);
        }
        for (size_t i = (size_t)gtid * 8; i < (size_t)T * D; i += (size_t)ngt * 8) { const f32x4 a = *(const f32x4*)(x + i), b = *(const f32x4*)(x + i + 4);
            v4u o; o.x = pk2(a[0], a[1]); o.y = pk2(a[2], a[3]); o.z = pk2(b[0], b[1]); o.w = pk2(b[2], b[3]); *(v4u*)(XB + i) = o; }
        for (size_t i = (size_t)gtid * 8; i < (size_t)NB * MEML * D; i += (size_t)ngt * 8) { const f32x4 a = *(const f32x4*)(args.in[1] + i), b = *(const f32x4*)(args.in[1] + i + 4);
            v4u o; o.x = pk2(a[0], a[1]); o.y = pk2(a[2], a[3]); o.z = pk2(b[0], b[1]); o.w = pk2(b[2], b[3]); *(v4u*)(MEMB + i) = o; }
        __syncthreads();
        for (int gj = vcu; gj < NG * 8; gj += G)
            p0_ssm_group(gj >> 3, gj & 7, tid, lds, args.in[7], args.in[8], args.in[9], args.in[10], args.in[11], args.in[12], args.in[13], SSM_W1, SSM_W2, LAM16);
        if (BOTH(0)) GRID_BAR();
    }

    if (IN(1)) {
        ProjSched S{(const char*)XB, (const char*)W_IN_T, (const char*)MEMB, (const char*)WKV_T, G, bx};
        EpiProj E{CV, AS, KB, VT};
        for (int rep = 0; rep < NREP(1); ++rep) pg8::gemm_phase<EpiProj, ProjSched, true>(lds, D, S, E);
        if (BOTH(1)) GRID_BAR();
    }

    if (IN(2)) {
        SsmSched<256> S{(const char*)AS, (const char*)SSM_W1, G, bx};
        EpiSend E{SEND};
        pg8::gemm_phase<EpiSend, SsmSched<256>, false>(lds, 256, S, E);
        if (BOTH(2)) GRID_BAR();
    }

    if (IN(3)) {
        constexpr int NSCAN = 16;
        if (vcu < NSCAN && G > NSCAN) {
            const int g = gw >> 2, b = gw & 3, p = lane;
            const float lr = LAM16[(g * 64 + p) * 2], li = LAM16[(g * 64 + p) * 2 + 1];
            float sr = 0.f, si = 0.f;
            const float* sp = SEND + ((size_t)(g * NCH + b * 256)) * 128 + p; bf16* ap = AS + ((size_t)(g * NCH + b * 256)) * 384 + 256 + p;
            float er[16], ei[16], nr_[16], ni_[16];
#pragma unroll
            for (int q = 0; q < 16; ++q) { er[q] = sp[(size_t)q * 128]; ei[q] = sp[(size_t)q * 128 + 64]; }
            for (int c0 = 0; c0 < SEQ / LC; c0 += 16) {
                const int cn = (c0 + 16 < SEQ / LC) ? c0 + 16 : c0;
#pragma unroll
                for (int q = 0; q < 16; ++q) { nr_[q] = sp[(size_t)(cn + q) * 128]; ni_[q] = sp[(size_t)(cn + q) * 128 + 64]; }
#pragma unroll
                for (int q = 0; q < 16; ++q) { ap[(size_t)(c0 + q) * 384] = (bf16)f2bf(sr); ap[(size_t)(c0 + q) * 384 + 64] = (bf16)f2bf(si);
                    const float nr = lr * sr - li * si + er[q], ni = lr * si + li * sr + ei[q]; sr = nr; si = ni; }
#pragma unroll
                for (int q = 0; q < 16; ++q) { er[q] = nr_[q]; ei[q] = ni_[q]; }
            }
        } else {
            const int nconv = (G > NSCAN) ? G - NSCAN : G, ci = (G > NSCAN) ? vcu - NSCAN : vcu;
            const int g_lo = (int)(((long)ci * (T / 8)) / nconv), g_hi = (int)(((long)(ci + 1) * (T / 8)) / nconv);
            LAS float* yl = (LAS float*)lds;
            const int c = tid;
            float wk[CW];
#pragma unroll
            for (int k = 0; k < CW; ++k) wk[k] = args.in[3][k * DC + c];
            const float cb = args.in[4][c];
            float win[38];
#pragma unroll
            for (int k = 0; k < 38; ++k) win[k] = 0.f;
            {
                const int t0 = g_lo * 8;
#pragma unroll
                for (int k = 0; k < 30; ++k) { const int t = t0 - 30 + k; float hv = 0.f;
                    if (t >= 0 && (t >> 12) == (t0 >> 12)) { const size_t o = (size_t)t * 1024 + c; hv = bf2f(CV[o]) * sigmoidf_(bf2f(CV[o + 512])); }
                    win[k] = hv; }
            }
            int rows = 0, row_t0 = g_lo * 8;
            for (int gi = g_lo; gi < g_hi; ++gi) {
                const int t0 = gi * 8;
                if ((t0 & (SEQ - 1)) == 0) {
#pragma unroll
                    for (int k = 0; k < 30; ++k) win[k] = 0.f; }
#pragma unroll
                for (int j = 0; j < 8; ++j) { const size_t o = (size_t)(t0 + j) * 1024 + c; win[30 + j] = bf2f(CV[o]) * sigmoidf_(bf2f(CV[o + 512])); }
#pragma unroll
                for (int j = 0; j < 8; ++j) { float a = cb;
#pragma unroll
                    for (int k = 0; k < CW; ++k) a += wk[k] * win[j + k];
                    yl[(rows + j) * 512 + c] = a; }
#pragma unroll
                for (int k = 0; k < 30; ++k) win[k] = win[k + 8];
                rows += 8;
                if (rows == 40 || gi + 1 == g_hi) {
                    __syncthreads();
                    for (int r = wave; r < rows; r += NWAVES) {
                        float v[8]; float s = 0.f;
#pragma unroll
                        for (int j = 0; j < 8; ++j) { v[j] = yl[r * 512 + lane + 64 * j]; s += v[j]; }
                        const float mean = wave_sum(s) * (1.0f / 512.0f); float s2 = 0.f;
#pragma unroll
                        for (int j = 0; j < 8; ++j) { v[j] -= mean; s2 += v[j] * v[j]; }
                        const float rstd = 1.0f / sqrtf(wave_sum(s2) * (1.0f / 512.0f) + EPS); float s3 = 0.f;
#pragma unroll
                        for (int j = 0; j < 8; ++j) { const int cc = lane + 64 * j; float y = v[j] * rstd * args.in[5][cc] + args.in[6][cc]; y = y * sigmoidf_(y); v[j] = y; s3 += y * y; }
                        const float rr = 1.0f / sqrtf(wave_sum(s3) * (1.0f / 512.0f) + EPS);
#pragma unroll
                        for (int j = 0; j < 8; ++j) { const int cc = lane + 64 * j; MERGED[(size_t)(row_t0 + r) * 1024 + cc] = (bf16)f2bf(v[j] * rr * args.in[17][cc]); }
                    }
                    __syncthreads();
                    row_t0 += rows; rows = 0;
                }
            }
        }
        if (BOTH(3)) GRID_BAR();
    }

    if (IN(4)) {
        SsmSched<384> S{(const char*)AS, (const char*)SSM_W2, G, bx};
        EpiSsmY E{AS, args.in[14], Z};
        pg8::gemm_phase<EpiSsmY, SsmSched<384>, false>(lds, 384, S, E);
        if (BOTH(4)) GRID_BAR();
    }

    if (IN(5)) {
        pg8::DenseSched S; S.init(Z, W_GLU_T, T, 512, 512, G, bx);
        EpiGlu E{Z, args.in[16], ZG};
        pg8::gemm_phase<EpiGlu, pg8::DenseSched, false>(lds, 512, S, E);
        if (BOTH(5)) GRID_BAR();
    }

    if (IN(6)) {
        for (int m = gw; m < T; m += ngw) {
            const f32x4 a = *(const f32x4*)(ZG + (size_t)m * 512 + lane * 4), b = *(const f32x4*)(ZG + (size_t)m * 512 + 256 + lane * 4);
            float s = (a[0] * a[0] + a[1] * a[1]) + (a[2] * a[2] + a[3] * a[3]) + (b[0] * b[0] + b[1] * b[1]) + (b[2] * b[2] + b[3] * b[3]);
            const float rr = 1.0f / sqrtf(wave_sum(s) * (1.0f / 512.0f) + EPS);
            const f32x4 ga = *(const f32x4*)(args.in[18] + lane * 4), gb = *(const f32x4*)(args.in[18] + 256 + lane * 4);
            v2u w; w.x = pk2(a[0] * rr * ga[0], a[1] * rr * ga[1]); w.y = pk2(a[2] * rr * ga[2], a[3] * rr * ga[3]);
            *(v2u*)(MERGED + (size_t)m * 1024 + 512 + lane * 4) = w;
            w.x = pk2(b[0] * rr * gb[0], b[1] * rr * gb[1]); w.y = pk2(b[2] * rr * gb[2], b[3] * rr * gb[3]);
            *(v2u*)(MERGED + (size_t)m * 1024 + 768 + lane * 4) = w;
        }
        if (BOTH(6)) GRID_BAR();
    }

#define GEMM_D_D(Aptr, Btptr, ...) do { \
        constexpr int NT = D / 64, TILES = (T / 64) * NT; \
        for (int t = gw; t < TILES; t += ngw) { \
            const int m0 = (t / NT) * 64, n0 = (t % NT) * 64; \
            const bf16* ar[4]; const bf16* br[4]; \
            _Pragma("unroll") for (int i = 0; i < 4; ++i) { ar[i] = (Aptr) + (size_t)(m0 + 16 * i + fr) * D + fq * 8; br[i] = (Btptr) + (size_t)(n0 + 16 * i + fr) * D + fq * 8; } \
            f32x4 acc[4][4]; zero_acc(acc); \
            wave_mma<4, 4>(ar, br, D, acc); \
            _Pragma("unroll") for (int i = 0; i < 4; ++i) _Pragma("unroll") for (int j = 0; j < 4; ++j) { const int m = m0 + 16 * i + fr, n = n0 + 16 * j + 4 * fq; const f32x4 v = acc[i][j]; __VA_ARGS__ } \
        } } while (0)

#define LN_ROWS(SRC, GAIN, BIAS, DSTF, DSTB) do { \
        for (int m = gw; m < T; m += ngw) { \
            f32x4 v[4]; float s = 0.f; \
            _Pragma("unroll") for (int j = 0; j < 4; ++j) { v[j] = *(const f32x4*)((SRC) + (size_t)m * D + j * 256 + lane * 4); s += (v[j][0] + v[j][1]) + (v[j][2] + v[j][3]); } \
            const float mean = wave_sum(s) * (1.0f / D); float s2 = 0.f; \
            _Pragma("unroll") for (int j = 0; j < 4; ++j) { v[j] = v[j] - mean; s2 += (v[j][0] * v[j][0] + v[j][1] * v[j][1]) + (v[j][2] * v[j][2] + v[j][3] * v[j][3]); } \
            const float rstd = 1.0f / sqrtf(wave_sum(s2) * (1.0f / D) + EPS); \
            _Pragma("unroll") for (int j = 0; j < 4; ++j) { const f32x4 gg = *(const f32x4*)((GAIN) + j * 256 + lane * 4), bb = *(const f32x4*)((BIAS) + j * 256 + lane * 4); \
                const f32x4 o = v[j] * rstd * gg + bb; *(f32x4*)((DSTF) + (size_t)m * D + j * 256 + lane * 4) = o; \
                if ((DSTB) != nullptr) { v2u w; w.x = pk2(o[0], o[1]); w.y = pk2(o[2], o[3]); *(v2u*)((DSTB) + (size_t)m * D + j * 256 + lane * 4) = w; } } \
        } } while (0)

    if (IN(7)) {
        pg8::DenseSched S; S.init(MERGED, W_OUT_T, T, D, D, G, bx);
        EpiResF32 E{x, Y1};
        pg8::gemm_phase<EpiResF32, pg8::DenseSched, false>(lds, D, S, E);
        if (BOTH(7)) GRID_BAR();
    }
    if (IN(8)) {
        LN_ROWS(Y1, args.in[20], args.in[21], X1, X1B);
        if (BOTH(8)) GRID_BAR();
    }
    if (IN(9)) {
        pg8::DenseSched S; S.init(X1B, WQ_T, T, D, D, G, bx);
        EpiBf16S E{Q, 0.0625f};
        pg8::gemm_phase<EpiBf16S, pg8::DenseSched, false>(lds, D, S, E);
        if (BOTH(9)) GRID_BAR();
    }
    if (IN(10)) {
        for (int rep = 0; rep < NREP(10); ++rep)
        for (int u = vcu; u < NB * NXH * (SEQ / 256); u += G) {
            const int bh = u >> 4, qb = u & 15, b = bh >> 2, h = bh & 3;
            int tl = tid; asm volatile("" : "+v"(tl));
            const int lfr = tl & 15, lfq = (tl >> 4) & 3;
            __syncthreads();
#pragma unroll
            for (int hb = 0; hb < 2; ++hb) { v4u tmp[8];
#pragma unroll
                for (int it = 0; it < 8; ++it) { const int idx = (hb * 8 + it) * NTHR + tl, kap = idx >> 5, c = idx & 31; tmp[it] = *(const v4u*)(KB + (size_t)(b * MEML + kap) * D + h * XHD + c * 8); }
#pragma unroll
                for (int it = 0; it < 8; ++it) { const int idx = (hb * 8 + it) * NTHR + tl, kap = idx >> 5, c = idx & 31;
                    const int rho = (kap & ~31) | (((kap >> 2) & 1) << 4) | (((kap >> 3) & 3) << 2) | (kap & 3);
                    *(LAS v4u*)(lds + rho * 512 + ((c ^ (rho & 15)) << 4)) = tmp[it]; } }
            __syncthreads();
            bf16x8 pf[2][8];
#pragma unroll
            for (int i = 0; i < 2; ++i) {
                bf16x8 qf[8];
                const bf16* qrow = Q + (size_t)(b * SEQ + qb * 256 + wave * 32 + i * 16 + lfr) * D + h * XHD + lfq * 8;
#pragma unroll
                for (int ks = 0; ks < 8; ++ks) qf[ks] = *(const bf16x8*)(qrow + ks * 32);
                f32x4 sc[16];
#pragma unroll
                for (int nt = 0; nt < 16; ++nt) { sc[nt] = (f32x4){0.f, 0.f, 0.f, 0.f};
#pragma unroll
                    for (int ks = 0; ks < 8; ++ks) { const bf16x8 kf = *(const LAS bf16x8*)(lds + (nt * 16 + lfr) * 512 + (((ks * 4 + lfq) ^ lfr) << 4));
                        sc[nt] = __builtin_amdgcn_mfma_f32_16x16x32_bf16(kf, qf[ks], sc[nt], 0, 0, 0); } }
                float mx = -3.0e38f;
#pragma unroll
                for (int nt = 0; nt < 16; ++nt) mx = fmaxf(mx, fmaxf(fmaxf(sc[nt][0], sc[nt][1]), fmaxf(sc[nt][2], sc[nt][3])));
                mx = fmaxf(mx, __shfl_xor(mx, 16)); mx = fmaxf(mx, __shfl_xor(mx, 32));
                float sum = 0.f;
#pragma unroll
                for (int nt = 0; nt < 16; ++nt) {
#pragma unroll
                    for (int r = 0; r < 4; ++r) { const float e = __expf(sc[nt][r] - mx); sc[nt][r] = e; sum += e; } }
                sum += __shfl_xor(sum, 16); sum += __shfl_xor(sum, 32);
                const float inv = 1.0f / sum;
#pragma unroll
                for (int ks = 0; ks < 8; ++ks) { v4u w; w.x = cvtpk(sc[2 * ks][0] * inv, sc[2 * ks][1] * inv); w.y = cvtpk(sc[2 * ks][2] * inv, sc[2 * ks][3] * inv);
                    w.z = cvtpk(sc[2 * ks + 1][0] * inv, sc[2 * ks + 1][1] * inv); w.w = cvtpk(sc[2 * ks + 1][2] * inv, sc[2 * ks + 1][3] * inv); pf[i][ks] = __builtin_bit_cast(bf16x8, w); }
                asm volatile("" ::: "memory");
            }
            __syncthreads();
#pragma unroll
            for (int hb = 0; hb < 2; ++hb) { v4u tmp[8];
#pragma unroll
                for (int it = 0; it < 8; ++it) { const int idx = (hb * 8 + it) * NTHR + tl, d = idx >> 5, c = idx & 31; tmp[it] = *(const v4u*)(VT + ((size_t)(b * 1024 + h * XHD + d)) * 256 + c * 8); }
#pragma unroll
                for (int it = 0; it < 8; ++it) { const int idx = (hb * 8 + it) * NTHR + tl, d = idx >> 5, c = idx & 31; *(LAS v4u*)(lds + d * 512 + ((c ^ (d & 15)) << 4)) = tmp[it]; } }
            __syncthreads();
#pragma unroll
            for (int dt = 0; dt < 16; ++dt) { f32x4 o0 = (f32x4){0.f, 0.f, 0.f, 0.f}, o1 = (f32x4){0.f, 0.f, 0.f, 0.f};
#pragma unroll
                for (int ks = 0; ks < 8; ++ks) { const bf16x8 vf = *(const LAS bf16x8*)(lds + (dt * 16 + lfr) * 512 + (((ks * 4 + lfq) ^ lfr) << 4));
                    o0 = __builtin_amdgcn_mfma_f32_16x16x32_bf16(vf, pf[0][ks], o0, 0, 0, 0); o1 = __builtin_amdgcn_mfma_f32_16x16x32_bf16(vf, pf[1][ks], o1, 0, 0, 0); }
                bf16* orow = O + (size_t)(b * SEQ + qb * 256 + wave * 32 + lfr) * D + h * XHD + dt * 16 + 4 * lfq;
                v2u w; w.x = cvtpk(o0[0], o0[1]); w.y = cvtpk(o0[2], o0[3]); *(v2u*)orow = w;
                w.x = cvtpk(o1[0], o1[1]); w.y = cvtpk(o1[2], o1[3]); *(v2u*)(orow + (size_t)16 * D) = w; }
        }
        __syncthreads();
        if (BOTH(10)) GRID_BAR();
    }
    if (IN(11)) {
        pg8::DenseSched S; S.init(O, WO_T, T, D, D, G, bx);
        EpiResF32 E{X1, Y1};
        pg8::gemm_phase<EpiResF32, pg8::DenseSched, false>(lds, D, S, E);
        if (BOTH(11)) GRID_BAR();
    }
    if (IN(12)) {
        LN_ROWS(Y1, args.in[26], args.in[27], X2, X2B);
        if (BOTH(12)) GRID_BAR();
    }
    if (IN(13)) {
        pg8::DenseSched S; S.init(X2B, WR_T, T, NE, D, G, bx);
        EpiF32 E{LOGITS, NE};
        pg8::gemm_phase<EpiF32, pg8::DenseSched, false>(lds, D, S, E);
        if (BOTH(13)) GRID_BAR();
    }
    if (IN(14)) {
        const f32x4 rb = *(const f32x4*)(args.in[29] + lane * 4);
        for (int m = gw; m < T; m += ngw) {
            const f32x4 lg = *(const f32x4*)(LOGITS + (size_t)m * NE + lane * 4);
            float sc[4], bs[4];
#pragma unroll
            for (int r = 0; r < 4; ++r) { sc[r] = sigmoidf_(lg[r]); bs[r] = sc[r] + rb[r]; }
            float m1 = fmaxf(bs[0], bs[1]), m2 = fminf(bs[0], bs[1]);
            { const float a = bs[2]; const float n1 = fmaxf(m1, a); m2 = fmaxf(m2, fminf(m1, a)); m1 = n1; }
            { const float a = bs[3]; const float n1 = fmaxf(m1, a); m2 = fmaxf(m2, fminf(m1, a)); m1 = n1; }
#pragma unroll
            for (int o = 1; o < 8; o <<= 1) { const float o1 = __shfl_xor(m1, o), o2 = __shfl_xor(m2, o); const float n1 = fmaxf(m1, o1); m2 = fmaxf(fminf(m1, o1), fmaxf(m2, o2)); m1 = n1; }
            const float gs = m1 + m2; const int myg = lane >> 3;
            int rank = 0;
#pragma unroll
            for (int g2 = 0; g2 < 8; ++g2) { const float og = __shfl(gs, g2 * 8); rank += (og > gs || (og == gs && g2 < myg)) ? 1 : 0; }
            const bool gsel = rank < TKG;
            unsigned key[4];
#pragma unroll
            for (int r = 0; r < 4; ++r) { const unsigned ub = __builtin_bit_cast(unsigned, bs[r]); const unsigned k = (ub & 0x80000000u) ? ~ub : (ub | 0x80000000u); key[r] = gsel ? k : 0u; }
            unsigned thr = 0u;
#pragma unroll 1
            for (int bit = 31; bit >= 0; --bit) { const unsigned cand = thr | (1u << bit);
                const int cnt = __builtin_popcountll(__ballot(key[0] >= cand)) + __builtin_popcountll(__ballot(key[1] >= cand)) + __builtin_popcountll(__ballot(key[2] >= cand)) + __builtin_popcountll(__ballot(key[3] >= cand));
                if (cnt >= TOPK) thr = cand; }
            unsigned long long gtm[4], eqm[4]; int ngt = 0;
#pragma unroll
            for (int r = 0; r < 4; ++r) { gtm[r] = __ballot(key[r] > thr); eqm[r] = __ballot(key[r] == thr); ngt += __builtin_popcountll(gtm[r]); }
            const int need = TOPK - ngt;
            const unsigned long long ltm = (1ull << lane) - 1ull;
            int eq_before = 0;
#pragma unroll
            for (int r = 0; r < 4; ++r) eq_before += __builtin_popcountll(eqm[r] & ltm);
            bool sel[4]; int eqmine = 0;
#pragma unroll
            for (int r = 0; r < 4; ++r) { const bool isgt = key[r] > thr, iseq = key[r] == thr; sel[r] = isgt || (iseq && (eq_before + eqmine) < need); eqmine += iseq ? 1 : 0; }
            float part = 0.f; unsigned long long sm[4];
#pragma unroll
            for (int r = 0; r < 4; ++r) { part += sel[r] ? sc[r] : 0.f; sm[r] = __ballot(sel[r]); }
            const float gsum = wave_sum(part);
            int slot0 = 0;
#pragma unroll
            for (int r = 0; r < 4; ++r) { if (sel[r]) { const int slot = slot0 + __builtin_popcountll(sm[r] & ltm); const int e = lane * 4 + r;
                    const unsigned pos = __hip_atomic_fetch_add(CNT + e * 64, 1u, RLX_AGENT);
                    TOPE[m * 8 + slot] = e; TOPP[m * 8 + slot] = (int)pos; GATE[m * 8 + slot] = ROUTED_SCALE * sc[r] / gsum; }
                slot0 += __builtin_popcountll(sm[r]); }
        }
        if (BOTH(14)) GRID_BAR();
    }
#define MOE_OFFSETS() LAS int* off = (LAS int*)(lds + 132096); LAS int* tst = off + 260; \
        __syncthreads(); \
        if (tid < 64) { int c4[4]; int s = 0, s2 = 0; \
            _Pragma("unroll") for (int r = 0; r < 4; ++r) { c4[r] = (int)__hip_atomic_load(CNT + (tid * 4 + r) * 64, RLX_AGENT); s += c4[r]; s2 += (c4[r] + 255) >> 8; } \
            int ps = s, ps2 = s2; \
            _Pragma("unroll") for (int o = 1; o < 64; o <<= 1) { const int a = __shfl_up(ps, o), a2 = __shfl_up(ps2, o); if (lane >= o) { ps += a; ps2 += a2; } } \
            int e0 = ps - s, t0 = ps2 - s2; \
            _Pragma("unroll") for (int r = 0; r < 4; ++r) { off[tid * 4 + r] = e0; tst[tid * 4 + r] = t0; e0 += c4[r]; t0 += (c4[r] + 255) >> 8; } \
            if (tid == 63) { off[256] = e0; tst[256] = t0; } } \
        __syncthreads();

    if (IN(15)) {
        MOE_OFFSETS();
        for (int a = gtid; a < NASSIGN; a += ngt) { const int e = TOPE[a], sl = off[e] + TOPP[a]; SLOT[a] = sl; STOK[sl] = a >> 3; SGATE[sl] = GATE[a]; }
        for (int t = gtid; t < T; t += ngt) STOK[NASSIGN + t] = t;
        if (BOTH(15)) GRID_BAR();
    }
    if (IN(16)) {
        MOE_OFFSETS();
        const int nmoe = tst[256];
        MoeSched<true> S{X2B, X2B, WGU_T, SH_GU_T, STOK, off, tst, nmoe, (nmoe + T / 256) * 2, G, bx, lds + 135168};
        EpiGateUp E{H, HS};
        for (int rep = 0; rep < NREP(16); ++rep) pg8::gemm_phase<EpiGateUp, MoeSched<true>, true>(lds, D, S, E);
        if (BOTH(16)) GRID_BAR();
    }
    if (IN(17)) {
        MOE_OFFSETS();
        const int nmoe = tst[256];
        MoeSched<false> S{H, HS, WD_T, SH_D_T, STOK, off, tst, nmoe, (nmoe + T / 256) * 4, G, bx, lds + 135168};
        EpiDown E{Y, YS, SGATE};
        for (int rep = 0; rep < NREP(17); ++rep) pg8::gemm_phase<EpiDown, MoeSched<false>, true>(lds, DE, S, E);
        if (BOTH(17)) GRID_BAR();
    }
    if (IN(18)) {
        for (int rep = 0; rep < NREP(18); ++rep)
        for (int m = gw; m < T; m += ngw) {
            f32x4 v[4];
#pragma unroll
            for (int j = 0; j < 4; ++j) { v[j] = *(const f32x4*)(X2 + (size_t)m * D + j * 256 + lane * 4) * ALPHA;
                const v2u ys = *(const v2u*)(YS + (size_t)m * D + j * 256 + lane * 4); v[j][0] += bflo(ys.x); v[j][1] += bfhi(ys.x); v[j][2] += bflo(ys.y); v[j][3] += bfhi(ys.y); }
#pragma unroll
            for (int k = 0; k < TOPK; ++k) { const int sl = SLOT[m * 8 + k];
#pragma unroll
                for (int j = 0; j < 4; ++j) { const v2u yy = *(const v2u*)(Y + (size_t)sl * D + j * 256 + lane * 4); v[j][0] += bflo(yy.x); v[j][1] += bfhi(yy.x); v[j][2] += bflo(yy.y); v[j][3] += bfhi(yy.y); } }
            float s = 0.f;
#pragma unroll
            for (int j = 0; j < 4; ++j) s += (v[j][0] + v[j][1]) + (v[j][2] + v[j][3]);
            const float mean = wave_sum(s) * (1.0f / D); float s2 = 0.f;
#pragma unroll
            for (int j = 0; j < 4; ++j) { v[j] = v[j] - mean; s2 += (v[j][0] * v[j][0] + v[j][1] * v[j][1]) + (v[j][2] * v[j][2] + v[j][3] * v[j][3]); }
            const float rstd = 1.0f / sqrtf(wave_sum(s2) * (1.0f / D) + EPS);
#pragma unroll
            for (int j = 0; j < 4; ++j) { const f32x4 gg = *(const f32x4*)(args.in[36] + j * 256 + lane * 4), bb = *(const f32x4*)(args.in[37] + j * 256 + lane * 4);
                *(f32x4*)(args.out + (size_t)m * D + j * 256 + lane * 4) = v[j] * rstd * gg + bb; }
        }
    }
#undef IN
#undef BOTH
}

extern "C" void kernel_launch(void* const* d_in, const int* in_sizes, int n_in, void* d_out, int out_size, void* d_ws, size_t ws_size, hipStream_t stream) {
    static int grid = 0;
    if (grid == 0) {
        if (n_in != 38 || out_size != T * D || ws_size < WS_END) { fprintf(stderr, "kernel_launch: unexpected shapes (n_in %d, out %d, ws %zu)\n", n_in, out_size, ws_size); grid = -1; return; }
        int dev = 0, cus = 0, per_cu = 0;
        if (hipGetDevice(&dev) != hipSuccess || hipDeviceGetAttribute(&cus, hipDeviceAttributeMultiprocessorCount, dev) != hipSuccess) { grid = -1; return; }
        if (hipFuncSetAttribute((const void*)fwd, hipFuncAttributeMaxDynamicSharedMemorySize, LDS_BYTES) != hipSuccess) { fprintf(stderr, "kernel_launch: hipFuncSetAttribute failed\n"); grid = -1; return; }
        if (hipOccupancyMaxActiveBlocksPerMultiprocessor(&per_cu, (const void*)fwd, NTHR, LDS_BYTES) != hipSuccess || per_cu < 1) { fprintf(stderr, "kernel_launch: occupancy query says %d\n", per_cu); }
        (void)hipGetLastError();
        grid = cus;
    }
    if (grid < 0) return;
    (void)hipMemsetAsync((char*)d_ws + WS_CTL, 0, CTL_ZERO_BYTES, stream);
    Args a{};
    for (int i = 0; i < 38; ++i) a.in[i] = (const float*)d_in[i];
    a.out = (float*)d_out; a.ws = (unsigned char*)d_ws;
#if MK_SPLIT
    for (int p = 0; p < N_PHASES; ++p) { a.ph_lo = p; a.ph_hi = p + 1; hipLaunchKernelGGL(fwd, dim3(grid), dim3(NTHR), LDS_BYTES, stream, a); }
#else
    a.ph_lo = 0; a.ph_hi = N_PHASES;
    hipLaunchKernelGGL(fwd, dim3(grid), dim3(NTHR), LDS_BYTES, stream, a);
#endif
}
```
